# Optimizing an MI355X kernel written in HIP

```python
import jax, jax.numpy as jnp
from jax import lax
import numpy as np

D_MODEL = 1024
BATCH = 8
SEQ = 2048
DEPTH = 4
DEC_BATCH = 128
DEC_SEQ = 1
PAST_LEN = 16384
PAGE_SIZE = 128

N_MIXERS = 3
EPS = 1e-6
POOL_WINDOWS = (2, 4, 8, 16)
POOL_GROUPS = len(POOL_WINDOWS)
D_POOL = 2 * D_MODEL
POOL_GW = D_POOL // POOL_GROUPS
POOL_HIST = max(POOL_WINDOWS) - 1
SGU_CHUNK = 128
D_SG = 2 * D_MODEL
SGU_GROUPS = 4
SGU_GW = D_SG // SGU_GROUPS
DN_DK = 128
DN_DV = 128
DN_HEADS = D_MODEL // DN_DK
DN_QK = DN_HEADS * DN_DK
DN_V = DN_HEADS * DN_DV
DN_CONV_CH = 2 * DN_QK + DN_V
DN_CONV = 4
DN_CHUNK = 64
DN_PROJ = DN_CONV_CH + DN_V + 2 * DN_HEADS

kernel_name = "hybrid_pool_sgu_gdn_decoder_step"

F32 = jnp.float32


def rmsnorm(x, gain):
    xf = x.astype(F32)
    y = xf * lax.rsqrt(jnp.mean(xf * xf, axis=-1, keepdims=True) + EPS)
    return (y * gain.astype(F32)).astype(x.dtype)


def l2norm(x):
    xf = x.astype(F32)
    return xf * lax.rsqrt(jnp.sum(xf * xf, axis=-1, keepdims=True) + EPS)


def pool_mixer(h, hist, start_pos, w_in, w_grp, scale, w_out):
    b, t, _ = h.shape
    xb, z = jnp.split(h @ w_in, 2, axis=-1)
    x_ext = jnp.concatenate([hist.astype(xb.dtype), xb], axis=1)
    cs = jnp.cumsum(jnp.pad(x_ext.astype(F32), ((0, 0), (1, 0), (0, 0))), axis=1)
    pos = start_pos + jnp.arange(t)
    means = []
    for gi, w in enumerate(POOL_WINDOWS):
        c0, c1 = gi * POOL_GW, (gi + 1) * POOL_GW
        win = cs[:, POOL_HIST + 1:POOL_HIST + 1 + t, c0:c1] - cs[:, POOL_HIST + 1 - w:POOL_HIST + 1 - w + t, c0:c1]
        cnt = jnp.minimum(pos + 1, w).astype(F32)
        means.append(win / cnt[None, :, None])
    pooled = jnp.concatenate(means, axis=-1) - xb.astype(F32)
    mixed = jnp.einsum('btgc,gcd->btgd', pooled.reshape(b, t, POOL_GROUPS, POOL_GW), w_grp.astype(F32))
    mixed = mixed.reshape(b, t, D_POOL) * scale.astype(F32) * jax.nn.silu(z.astype(F32))
    y = mixed.astype(h.dtype) @ w_out
    return y, x_ext[:, -POOL_HIST:]


def sgu_mixer(h, w_in, ln_g, ln_b, w_s, b_s, w_out):
    b, t, _ = h.shape
    u, v, z = jnp.split(h @ w_in, 3, axis=-1)
    u = jax.nn.gelu(u.astype(F32), approximate=False)
    v = jax.nn.gelu(v.astype(F32), approximate=False)
    mu = jnp.mean(v, axis=-1, keepdims=True)
    var = jnp.mean(jnp.square(v - mu), axis=-1, keepdims=True)
    v = (v - mu) * lax.rsqrt(var + EPS) * ln_g.astype(F32) + ln_b.astype(F32)
    n = -(-t // SGU_CHUNK)
    vp = jnp.pad(v, ((0, 0), (0, n * SGU_CHUNK - t), (0, 0))).reshape(b, n, SGU_CHUNK, SGU_GROUPS, SGU_GW)
    causal = jnp.tril(jnp.ones((SGU_CHUNK, SGU_CHUNK), dtype=bool))
    ws = jnp.where(causal, w_s.astype(F32), 0.0)
    s = jnp.einsum('gij,bnjgc->bnigc', ws, vp) + b_s.astype(F32).T[None, None, :, :, None]
    s = s.reshape(b, n * SGU_CHUNK, D_SG)[:, :t]
    y = (u * s * jax.nn.silu(z.astype(F32))).astype(h.dtype) @ w_out
    return y, v.astype(h.dtype)


def gated_delta_chunked(q, k, v, g, beta, s0):
    b, t = q.shape[:2]
    n = -(-t // DN_CHUNK)
    pad = n * DN_CHUNK - t

    def to_chunks(a):
        a = jnp.pad(a, ((0, 0), (0, pad)) + ((0, 0),) * (a.ndim - 2))
        a = a.reshape((b, n, DN_CHUNK) + a.shape[2:])
        return jnp.moveaxis(jnp.moveaxis(a, 3, 2), 1, 0)

    qc, kc, vc, gc, bc = [to_chunks(a) for a in (q, k, v, g, beta)]
    gam = jnp.cumsum(gc, axis=-1)
    idx = jnp.arange(DN_CHUNK)
    incl = idx[:, None] >= idx[None, :]
    strict = idx[:, None] > idx[None, :]
    dec = jnp.exp(jnp.where(incl, gam[..., :, None] - gam[..., None, :], -jnp.inf))
    m = jnp.where(strict, bc[..., :, None] * jnp.einsum('nbhid,nbhjd->nbhij', kc, kc) * dec, 0.0)
    rhs = jnp.concatenate([bc[..., None] * vc, (bc * jnp.exp(gam))[..., None] * kc], axis=-1)
    sol = lax.linalg.triangular_solve(m + jnp.eye(DN_CHUNK, dtype=m.dtype), rhs,
                                      left_side=True, lower=True, unit_diagonal=True)
    u_val, w_k = sol[..., :DN_DV], sol[..., DN_DV:]
    qk = jnp.einsum('nbhid,nbhjd->nbhij', qc, kc) * dec
    q_dec = qc * jnp.exp(gam)[..., None]
    k_tail = kc * jnp.exp(gam[..., -1:] - gam)[..., None]
    a_last = jnp.exp(gam[..., -1])

    def step(s, xs):
        u_c, wk_c, qk_c, qd_c, kt_c, al_c = xs
        w = u_c - jnp.einsum('bhck,bhkv->bhcv', wk_c, s)
        o = jnp.einsum('bhck,bhkv->bhcv', qd_c, s) + jnp.einsum('bhij,bhjv->bhiv', qk_c, w)
        s = al_c[..., None, None] * s + jnp.einsum('bhck,bhcv->bhkv', kt_c, w)
        return s, o

    s_fin, o = lax.scan(step, s0.astype(F32), (u_val, w_k, qk, q_dec, k_tail, a_last))
    o = jnp.moveaxis(jnp.moveaxis(o, 0, 1), 2, 3)
    o = o.reshape(b, n * DN_CHUNK, DN_HEADS, DN_DV)[:, :t]
    return o, s_fin


def delta_mixer(h, conv_hist, s0, w_in, conv_w, a_log, dt_bias, o_gain, w_out):
    b, t, _ = h.shape
    proj = h @ w_in
    qkv = proj[..., :DN_CONV_CH]
    z = proj[..., DN_CONV_CH:DN_CONV_CH + DN_V]
    a = proj[..., DN_CONV_CH + DN_V:DN_CONV_CH + DN_V + DN_HEADS]
    bb = proj[..., DN_CONV_CH + DN_V + DN_HEADS:]
    x_ext = jnp.concatenate([conv_hist.astype(qkv.dtype), qkv], axis=1)
    cw = conv_w.astype(F32)
    conv = sum(x_ext[:, j:j + t].astype(F32) * cw[j] for j in range(DN_CONV))
    conv = jax.nn.silu(conv)
    q = l2norm(conv[..., :DN_QK].reshape(b, t, DN_HEADS, DN_DK)) * (DN_DK ** -0.5)
    k = l2norm(conv[..., DN_QK:2 * DN_QK].reshape(b, t, DN_HEADS, DN_DK))
    v = conv[..., 2 * DN_QK:].reshape(b, t, DN_HEADS, DN_DV)
    g = -jnp.exp(a_log.astype(F32)) * jax.nn.softplus(a.astype(F32) + dt_bias.astype(F32))
    beta = jax.nn.sigmoid(bb.astype(F32))
    o, s_new = gated_delta_chunked(q, k, v, g, beta, s0)
    o = rmsnorm(o, o_gain).reshape(b, t, DN_V) * jax.nn.silu(z.astype(F32))
    y = o.astype(h.dtype) @ w_out
    return y, x_ext[:, -(DN_CONV - 1):], s_new


def setup_inputs(seed: int = 0) -> dict:
    key = jax.random.key(seed)
    ks = iter(jax.random.split(key, 64))

    def nrm(shape, scale):
        return jax.random.normal(next(ks), shape, F32) * scale

    def gain(n):
        return 1.0 + nrm((n,), 0.02)

    def pool_params():
        return (nrm((D_MODEL, 2 * D_POOL), D_MODEL ** -0.5),
                nrm((POOL_GROUPS, POOL_GW, POOL_GW), POOL_GW ** -0.5),
                gain(D_POOL),
                nrm((D_POOL, D_MODEL), D_POOL ** -0.5))

    inp = {}
    inp["x_prompt"] = nrm((BATCH, SEQ, D_MODEL), 1.0)
    inp["x_sample"] = nrm((DEC_BATCH, DEC_SEQ, D_MODEL), 1.0)
    inp["state_pool_l0"] = nrm((DEC_BATCH, POOL_HIST, D_POOL), 1.0)
    inp["state_conv_l2"] = nrm((DEC_BATCH, DN_CONV - 1, DN_CONV_CH), 1.0)
    inp["state_delta_l2"] = nrm((DEC_BATCH, DN_HEADS, DN_DK, DN_DV), 0.3)
    inp["state_pool_l3"] = nrm((DEC_BATCH, POOL_HIST, D_POOL), 1.0)

    inp["l0_norm"] = gain(D_MODEL)
    p = pool_params()
    inp["l0_pool_w_in"], inp["l0_pool_w_grp"], inp["l0_pool_scale"], inp["l0_pool_w_out"] = p

    inp["l1_norm"] = gain(D_MODEL)
    inp["l1_sgu_w_in"] = nrm((D_MODEL, 3 * D_SG), D_MODEL ** -0.5)
    inp["l1_sgu_ln_g"] = gain(D_SG)
    inp["l1_sgu_ln_b"] = nrm((D_SG,), 0.02)
    inp["l1_sgu_w_s"] = nrm((SGU_GROUPS, SGU_CHUNK, SGU_CHUNK), SGU_CHUNK ** -0.5)
    inp["l1_sgu_b_s"] = nrm((SGU_GROUPS, SGU_CHUNK), 0.1)
    inp["l1_sgu_w_out"] = nrm((D_SG, D_MODEL), D_SG ** -0.5)

    inp["l2_norm"] = gain(D_MODEL)
    inp["l2_dn_w_in"] = nrm((D_MODEL, DN_PROJ), D_MODEL ** -0.5)
    inp["l2_dn_conv_w"] = nrm((DN_CONV, DN_CONV_CH), DN_CONV ** -0.5)
    inp["l2_dn_a_log"] = jnp.log(jax.random.uniform(next(ks), (DN_HEADS,), F32, 1.0, 16.0))
    dt = jnp.exp(jax.random.uniform(next(ks), (DN_HEADS,), F32) * (jnp.log(0.1) - jnp.log(0.001)) + jnp.log(0.001))
    inp["l2_dn_dt_bias"] = dt + jnp.log(-jnp.expm1(-dt))
    inp["l2_dn_o_gain"] = gain(DN_DV)
    inp["l2_dn_w_out"] = nrm((DN_V, D_MODEL), DN_V ** -0.5)

    inp["l3_norm"] = gain(D_MODEL)
    p = pool_params()
    inp["l3_pool_w_in"], inp["l3_pool_w_grp"], inp["l3_pool_scale"], inp["l3_pool_w_out"] = p

    inp["final_norm"] = gain(D_MODEL)
    return inp


def reference(x_prompt, x_sample, state_pool_l0, state_conv_l2, state_delta_l2, state_pool_l3,
              l0_norm, l0_pool_w_in, l0_pool_w_grp, l0_pool_scale, l0_pool_w_out,
              l1_norm, l1_sgu_w_in, l1_sgu_ln_g, l1_sgu_ln_b, l1_sgu_w_s, l1_sgu_b_s, l1_sgu_w_out,
              l2_norm, l2_dn_w_in, l2_dn_conv_w, l2_dn_a_log, l2_dn_dt_bias, l2_dn_o_gain, l2_dn_w_out,
              l3_norm, l3_pool_w_in, l3_pool_w_grp, l3_pool_scale, l3_pool_w_out,
              final_norm):
    norms = (l0_norm, l1_norm, l2_norm, l3_norm)
    layer_params = (
        (l0_pool_w_in, l0_pool_w_grp, l0_pool_scale, l0_pool_w_out),
        (l1_sgu_w_in, l1_sgu_ln_g, l1_sgu_ln_b, l1_sgu_w_s, l1_sgu_b_s, l1_sgu_w_out),
        (l2_dn_w_in, l2_dn_conv_w, l2_dn_a_log, l2_dn_dt_bias, l2_dn_o_gain, l2_dn_w_out),
        (l3_pool_w_in, l3_pool_w_grp, l3_pool_scale, l3_pool_w_out),
    )
    sample_states = ((state_pool_l0,), (), (state_conv_l2, state_delta_l2), (state_pool_l3,))
    bp = x_prompt.shape[0]
    xp, xs = x_prompt, x_sample
    new_states = []
    for i in range(DEPTH):
        hp = rmsnorm(xp, norms[i])
        hs = rmsnorm(xs, norms[i])
        prm = layer_params[i]
        kind = i % N_MIXERS
        if kind == 0:
            hist0 = jnp.zeros((bp, POOL_HIST, D_POOL), xp.dtype)
            yp, pool_p = pool_mixer(hp, hist0, 0, *prm)
            ys, pool_s = pool_mixer(hs, sample_states[i][0], PAST_LEN, *prm)
            new_states.append((pool_p, pool_s))
        elif kind == 1:
            yp, _ = sgu_mixer(hp, *prm)
            ys, v_s = sgu_mixer(hs, *prm)
            new_states.append((v_s,))
        else:
            conv0 = jnp.zeros((bp, DN_CONV - 1, DN_CONV_CH), xp.dtype)
            s0 = jnp.zeros((bp, DN_HEADS, DN_DK, DN_DV), F32)
            yp, conv_p, dn_p = delta_mixer(hp, conv0, s0, *prm)
            ys, conv_s, dn_s = delta_mixer(hs, sample_states[i][0], sample_states[i][1], *prm)
            new_states.append((conv_p, conv_s, dn_p, dn_s))
        xp = xp + yp
        xs = xs + ys
    y_prompt = rmsnorm(xp, final_norm)
    y_sample = rmsnorm(xs, final_norm)
    (pool0_p, pool0_s), (sgu1_s,), (conv2_p, conv2_s, dn2_p, dn2_s), (pool3_p, pool3_s) = new_states
    return (y_prompt, y_sample, pool0_p, pool0_s, sgu1_s, conv2_p, conv2_s, dn2_p, dn2_s, pool3_p, pool3_s)
```

```cpp
#include <hip/hip_runtime.h>
#include <hip/hip_cooperative_groups.h>
#include <cstdio>
namespace cg = cooperative_groups;

#ifndef PH_MASK
#define PH_MASK 0x7fff
#endif
#ifndef MULTI_LAUNCH
#define MULTI_LAUNCH 1
#endif

typedef unsigned short u16;
using bf16x8 = __attribute__((ext_vector_type(8))) short;
using f32x4 = __attribute__((ext_vector_type(4))) float;
#define DI __device__ __forceinline__

constexpr int T = 16512;
constexpr int TP = 16384;
constexpr float EPS = 1e-6f;
constexpr int NPHASE = 15;
constexpr int LDS_BYTES = 73728;

constexpr size_t O_Y = 0;
constexpr size_t O_POOL0P = (size_t)T * 1024;
constexpr size_t O_POOL0S = O_POOL0P + 8 * 15 * 2048;
constexpr size_t O_SGUV = O_POOL0S + 128 * 15 * 2048;
constexpr size_t O_CONVP = O_SGUV + 128 * 2048;
constexpr size_t O_CONVS = O_CONVP + 8 * 3 * 3072;
constexpr size_t O_DNP = O_CONVS + 128 * 3 * 3072;
constexpr size_t O_DNS = O_DNP + 8 * 8 * 128 * 128;
constexpr size_t O_POOL3P = O_DNS + (size_t)128 * 8 * 128 * 128;
constexpr size_t O_POOL3S = O_POOL3P + 8 * 15 * 2048;

constexpr size_t W_0IN = 0;
constexpr size_t W_0GRP = W_0IN + (size_t)4096 * 1024 * 2;
constexpr size_t W_0OUT = W_0GRP + (size_t)4 * 512 * 512 * 2;
constexpr size_t W_1IN = W_0OUT + (size_t)1024 * 2048 * 2;
constexpr size_t W_1WS = W_1IN + (size_t)6144 * 1024 * 2;
constexpr size_t W_1OUT = W_1WS + (size_t)4 * 128 * 128 * 2;
constexpr size_t W_2IN = W_1OUT + (size_t)1024 * 2048 * 2;
constexpr size_t W_2OUT = W_2IN + (size_t)4224 * 1024 * 2;
constexpr size_t W_3IN = W_2OUT + (size_t)1024 * 1024 * 2;
constexpr size_t W_3GRP = W_3IN + (size_t)4096 * 1024 * 2;
constexpr size_t W_3OUT = W_3GRP + (size_t)4 * 512 * 512 * 2;
constexpr size_t W_A = W_3OUT + (size_t)1024 * 2048 * 2;
constexpr size_t ABC = (size_t)T * 2048 * 2;
constexpr size_t W_B = W_A + ABC;
constexpr size_t W_C = W_B + ABC;
constexpr size_t W_STAT = W_C + ABC;
constexpr size_t W_G = W_STAT + (size_t)15 * T * 4;
constexpr size_t W_BETA = W_G + (size_t)T * 8 * 4;
constexpr size_t W_ALAST = W_BETA + (size_t)T * 8 * 4;
constexpr size_t W_WSS = W_ALAST + 2048 * 4;
constexpr size_t W_KSS = W_WSS + 128 * 8 * 128 * 4;
constexpr size_t W_EGS = W_KSS + 128 * 8 * 128 * 4;
constexpr size_t W_END = W_EGS + 128 * 8 * 4;
constexpr size_t A_HALO = 0;
constexpr size_t A_KTT = A_HALO + (size_t)256 * 3 * 3072 * 2;
constexpr size_t A_QK = A_KTT + (size_t)2048 * 8192 * 2;

struct Params {
  const float* in[31];
  float* out;
  char* ws;
};

DI int TID() { int t = threadIdx.x; asm volatile("" : "+v"(t)); return t; }
DI float bf2f(u16 x) { return __uint_as_float(((unsigned)x) << 16); }
typedef __bf16 bf16v2_t __attribute__((ext_vector_type(2)));
typedef float f32v2_t __attribute__((ext_vector_type(2)));
DI unsigned pack2(float a, float b) {
  f32v2_t f = {a, b};
  bf16v2_t h = __builtin_convertvector(f, bf16v2_t);
  return __builtin_bit_cast(unsigned, h);
}
DI u16 f2bf(float x) { return (u16)(pack2(x, 0.f) & 0xffffu); }
DI void unpack8(const uint4& u, float* f) {
  f[0] = __uint_as_float(u.x << 16); f[1] = __uint_as_float(u.x & 0xffff0000u);
  f[2] = __uint_as_float(u.y << 16); f[3] = __uint_as_float(u.y & 0xffff0000u);
  f[4] = __uint_as_float(u.z << 16); f[5] = __uint_as_float(u.z & 0xffff0000u);
  f[6] = __uint_as_float(u.w << 16); f[7] = __uint_as_float(u.w & 0xffff0000u);
}
DI uint4 pack8(const float* f) {
  uint4 u;
  u.x = pack2(f[0], f[1]); u.y = pack2(f[2], f[3]); u.z = pack2(f[4], f[5]); u.w = pack2(f[6], f[7]);
  return u;
}
DI float silu_f(float x) { return x / (1.f + __expf(-x)); }
DI float gelu_f(float x) { return 0.5f * x * (1.f + erff(x * 0.70710678118654752f)); }
DI float wave_sum(float v) {
#pragma unroll
  for (int o = 32; o > 0; o >>= 1) v += __shfl_xor(v, o, 64);
  return v;
}
DI float sum8(float v) {
  v += __shfl_xor(v, 1, 64); v += __shfl_xor(v, 2, 64); v += __shfl_xor(v, 4, 64);
  return v;
}
DI float sum16(float v) {
  v += __shfl_xor(v, 1, 64); v += __shfl_xor(v, 2, 64); v += __shfl_xor(v, 4, 64); v += __shfl_xor(v, 8, 64);
  return v;
}

template <class AL, class BL, class EP>
DI void gemm_tile(char* smem, int nk, AL aload, BL bload, EP epi) {
  const int tid = TID(), lane = tid & 63, wid = tid >> 6;
  const int wr = wid >> 1, wc = wid & 1, fr = lane & 15, fq = lane >> 4;
  f32x4 acc[4][4];
#pragma unroll
  for (int m = 0; m < 4; ++m)
#pragma unroll
    for (int n = 0; n < 4; ++n) acc[m][n] = f32x4{0.f, 0.f, 0.f, 0.f};
  const int crow = tid >> 3, ck = (tid & 7) * 8;
  uint4 ra[4], rb[4];
#pragma unroll
  for (int i = 0; i < 4; ++i) { ra[i] = aload(crow + 32 * i, ck); rb[i] = bload(crow + 32 * i, ck); }
  __syncthreads();
#pragma unroll
  for (int i = 0; i < 4; ++i) {
    *(uint4*)(smem + (crow + 32 * i) * 144 + ck * 2) = ra[i];
    *(uint4*)(smem + 18432 + (crow + 32 * i) * 144 + ck * 2) = rb[i];
  }
  __syncthreads();
  for (int kt = 0; kt < nk; ++kt) {
    const int cur = kt & 1;
    const bool more = (kt + 1 < nk);
    if (more) {
#pragma unroll
      for (int i = 0; i < 4; ++i) { ra[i] = aload(crow + 32 * i, (kt + 1) * 64 + ck); rb[i] = bload(crow + 32 * i, (kt + 1) * 64 + ck); }
    }
    const char* As = smem + cur * 36864;
    const char* Bs = As + 18432;
#pragma unroll
    for (int ks = 0; ks < 2; ++ks) {
      bf16x8 a[4], b[4];
#pragma unroll
      for (int m = 0; m < 4; ++m) a[m] = *(const bf16x8*)(As + (wr * 64 + m * 16 + fr) * 144 + ks * 64 + fq * 16);
#pragma unroll
      for (int n = 0; n < 4; ++n) b[n] = *(const bf16x8*)(Bs + (wc * 64 + n * 16 + fr) * 144 + ks * 64 + fq * 16);
#pragma unroll
      for (int m = 0; m < 4; ++m)
#pragma unroll
        for (int n = 0; n < 4; ++n) acc[m][n] = __builtin_amdgcn_mfma_f32_16x16x32_bf16(a[m], b[n], acc[m][n], 0, 0, 0);
    }
    if (more) {
      char* Ad = smem + (cur ^ 1) * 36864;
#pragma unroll
      for (int i = 0; i < 4; ++i) {
        *(uint4*)(Ad + (crow + 32 * i) * 144 + ck * 2) = ra[i];
        *(uint4*)(Ad + 18432 + (crow + 32 * i) * 144 + ck * 2) = rb[i];
      }
    }
    __syncthreads();
  }
  float* st = (float*)(smem + wid * 17408);
#pragma unroll
  for (int m = 0; m < 4; ++m)
#pragma unroll
    for (int n = 0; n < 4; ++n)
#pragma unroll
      for (int j = 0; j < 4; ++j) st[(m * 16 + fq * 4 + j) * 68 + n * 16 + fr] = acc[m][n][j];
  __syncthreads();
#pragma unroll 1
  for (int i = 0; i < 8; ++i) {
    const int r = (lane >> 3) + 8 * i, c = (lane & 7) * 8;
    f32x4 v0 = *(const f32x4*)(st + r * 68 + c);
    f32x4 v1 = *(const f32x4*)(st + r * 68 + c + 4);
    epi(wr * 64 + r, wc * 64 + c, v0, v1);
  }
}

DI void store8bf(u16* dst, const float* v) { *(uint4*)dst = pack8(v); }
DI void store8f(float* dst, const float* v) {
  *(f32x4*)dst = f32x4{v[0], v[1], v[2], v[3]};
  *(f32x4*)(dst + 4) = f32x4{v[4], v[5], v[6], v[7]};
}

DI void transpose_job(char* smem, const float* W, int K, int N, int Npad, const float* kgain, const float* nscale,
                      u16* Wt, int vb, int nb) {
  const int tid = TID();
  const int tk = K / 64, tn = Npad / 64;
  float* tile = (float*)smem;
  for (int t = vb; t < tk * tn; t += nb) {
    const int k0 = (t % tk) * 64, n0 = (t / tk) * 64;
    __syncthreads();
    {
      const int nn = tid & 63, n = n0 + nn;
      const float ns = (nscale && n < N) ? nscale[n] : 1.f;
#pragma unroll 4
      for (int i = 0; i < 16; ++i) {
        const int kk = (tid >> 6) + 4 * i;
        float v = (n < N) ? W[(size_t)(k0 + kk) * N + n] : 0.f;
        if (kgain) v *= kgain[k0 + kk];
        tile[kk * 65 + nn] = v * ns;
      }
    }
    __syncthreads();
    {
      const int nn = tid >> 2, kc = (tid & 3) * 16;
      float f[16];
#pragma unroll
      for (int q = 0; q < 16; ++q) f[q] = tile[(kc + q) * 65 + nn];
      u16* dst = Wt + (size_t)(n0 + nn) * K + k0 + kc;
      *(uint4*)dst = pack8(f);
      *(uint4*)(dst + 8) = pack8(f + 8);
    }
  }
}

DI void phase_prep(const Params& p, char* smem, int vb, int nb) {
  char* ws = p.ws;
  transpose_job(smem, p.in[7], 1024, 4096, 4096, p.in[6], nullptr, (u16*)(ws + W_0IN), vb, nb);
  for (int g = 0; g < 4; ++g)
    transpose_job(smem, p.in[8] + (size_t)g * 512 * 512, 512, 512, 512, nullptr, p.in[9] + g * 512,
                  (u16*)(ws + W_0GRP) + (size_t)g * 512 * 512, vb, nb);
  transpose_job(smem, p.in[10], 2048, 1024, 1024, nullptr, nullptr, (u16*)(ws + W_0OUT), vb, nb);
  transpose_job(smem, p.in[12], 1024, 6144, 6144, p.in[11], nullptr, (u16*)(ws + W_1IN), vb, nb);
  transpose_job(smem, p.in[17], 2048, 1024, 1024, nullptr, nullptr, (u16*)(ws + W_1OUT), vb, nb);
  transpose_job(smem, p.in[19], 1024, 4112, 4224, p.in[18], nullptr, (u16*)(ws + W_2IN), vb, nb);
  transpose_job(smem, p.in[24], 1024, 1024, 1024, nullptr, nullptr, (u16*)(ws + W_2OUT), vb, nb);
  transpose_job(smem, p.in[26], 1024, 4096, 4096, p.in[25], nullptr, (u16*)(ws + W_3IN), vb, nb);
  for (int g = 0; g < 4; ++g)
    transpose_job(smem, p.in[27] + (size_t)g * 512 * 512, 512, 512, 512, nullptr, p.in[28] + g * 512,
                  (u16*)(ws + W_3GRP) + (size_t)g * 512 * 512, vb, nb);
  transpose_job(smem, p.in[29], 2048, 1024, 1024, nullptr, nullptr, (u16*)(ws + W_3OUT), vb, nb);

  const int gtid = vb * 256 + TID(), gn = nb * 256;
  {
    u16* w16 = (u16*)(ws + W_1WS);
    const float* wsf = p.in[15];
    for (int i = gtid; i < 4 * 128 * 128; i += gn) {
      const int jj = i & 127, ii = (i >> 7) & 127;
      w16[i] = (jj <= ii) ? f2bf(wsf[i]) : (u16)0;
    }
  }
  {
    float* st = (float*)(ws + W_STAT);
    for (int i = T + gtid; i < 15 * T; i += gn) st[i] = 0.f;
  }
  {
    u16* xb16 = (u16*)(p.out + O_DNS);
    float* sumsq = (float*)(ws + W_STAT);
    const int lane = gtid & 63;
    const int gw = gtid >> 6, nw = gn >> 6;
    for (int row = gw; row < T; row += nw) {
      const float* src = (row < TP) ? p.in[0] + (size_t)row * 1024 : p.in[1] + (size_t)(row - TP) * 1024;
      float s = 0.f;
#pragma unroll
      for (int i = 0; i < 4; ++i) {
        const int c = (lane + 64 * i) * 4;
        f32x4 v = *(const f32x4*)(src + c);
        s += v[0] * v[0] + v[1] * v[1] + v[2] * v[2] + v[3] * v[3];
        uint2 o; o.x = pack2(v[0], v[1]); o.y = pack2(v[2], v[3]);
        *(uint2*)(xb16 + (size_t)row * 1024 + c) = o;
      }
      s = wave_sum(s);
      if (lane == 0) sumsq[row] = s;
    }
  }
  for (int i = gtid; i < 128 * 14 * 512; i += gn) {
    const int c4 = i & 511, r = (i >> 9) % 14, b = i / (14 * 512);
    const size_t so = ((size_t)(b * 15 + r + 1) * 2048) + c4 * 4, dof = ((size_t)(b * 15 + r) * 2048) + c4 * 4;
    *(f32x4*)(p.out + O_POOL0S + dof) = *(const f32x4*)(p.in[2] + so);
    *(f32x4*)(p.out + O_POOL3S + dof) = *(const f32x4*)(p.in[5] + so);
  }
  for (int i = gtid; i < 128 * 2 * 768; i += gn) {
    const int c4 = i % 768, r = (i / 768) & 1, b = i / (2 * 768);
    *(f32x4*)(p.out + O_CONVS + ((size_t)(b * 3 + r) * 3072) + c4 * 4) =
        *(const f32x4*)(p.in[3] + ((size_t)(b * 3 + r + 1) * 3072) + c4 * 4);
  }
}

template <int KIND>
DI void phase_inproj(const Params& p, char* smem, int vb, int nb, int layer) {
  char* ws = p.ws;
  constexpr int NT = (KIND == 0) ? 32 : (KIND == 1 ? 48 : 33);
  const u16* Wt = (const u16*)(ws + (layer == 0 ? W_0IN : layer == 1 ? W_1IN : layer == 2 ? W_2IN : W_3IN));
  const u16* xb16 = (const u16*)(p.out + O_DNS);
  const float* sumsq = (const float*)(ws + W_STAT) + (size_t)layer * T;
  u16* Ab = (u16*)(ws + W_A);
  u16* Bb = (u16*)(ws + W_B);
  u16* Cb = (u16*)(ws + W_C);
  float* lnstat = (float*)(ws + W_STAT) + (size_t)5 * T;
  float* Gb = (float*)(ws + W_G);
  float* Betab = (float*)(ws + W_BETA);
  u16* halo = (u16*)(ws + W_A + A_HALO);
  float* out = p.out;
  const float* a_log = p.in[21];
  const float* dt_bias = p.in[22];
  const size_t o_poolp = (layer == 0) ? O_POOL0P : O_POOL3P;
  const size_t o_pools = (layer == 0) ? O_POOL0S : O_POOL3S;
  for (int t = vb; t < 129 * NT; t += nb) {
    const int mt = t / NT, nt = t % NT;
    const u16* Ap = xb16 + (size_t)mt * 128 * 1024;
    const u16* Bp = Wt + (size_t)nt * 128 * 1024;
    auto aload = [&](int r, int k) -> uint4 { return *(const uint4*)(Ap + (size_t)r * 1024 + k); };
    auto bload = [&](int r, int k) -> uint4 { return *(const uint4*)(Bp + (size_t)r * 1024 + k); };
    auto epi = [&](int rl, int cl, const f32x4& v0, const f32x4& v1) {
      const int row = mt * 128 + rl, col = nt * 128 + cl;
      const float rs = rsqrtf(sumsq[row] * (1.f / 1024.f) + EPS);
      float v[8];
#pragma unroll
      for (int q = 0; q < 4; ++q) { v[q] = v0[q] * rs; v[4 + q] = v1[q] * rs; }
      if (KIND == 0) {
        if (col < 2048) {
          store8bf(Bb + (size_t)row * 2048 + col, v);
          if (row < TP) {
            const int tt = row & 2047, b = row >> 11;
            if (tt >= 2033) store8f(out + o_poolp + ((size_t)(b * 15 + tt - 2033) * 2048) + col, v);
          } else {
            store8f(out + o_pools + ((size_t)((row - TP) * 15 + 14) * 2048) + col, v);
          }
        } else {
#pragma unroll
          for (int q = 0; q < 8; ++q) v[q] = silu_f(v[q]);
          store8bf(Cb + (size_t)row * 2048 + (col - 2048), v);
        }
      } else if (KIND == 1) {
        if (col < 2048) {
#pragma unroll
          for (int q = 0; q < 8; ++q) v[q] = gelu_f(v[q]);
          store8bf(Ab + (size_t)row * 2048 + col, v);
        } else if (col < 4096) {
          float s1 = 0.f, s2 = 0.f;
#pragma unroll
          for (int q = 0; q < 8; ++q) { v[q] = gelu_f(v[q]); s1 += v[q]; s2 += v[q] * v[q]; }
          store8bf(Bb + (size_t)row * 2048 + (col - 2048), v);
          s1 = sum8(s1); s2 = sum8(s2);
          if ((__lane_id() & 7) == 0) { atomicAdd(&lnstat[row * 2], s1); atomicAdd(&lnstat[row * 2 + 1], s2); }
        } else {
#pragma unroll
          for (int q = 0; q < 8; ++q) v[q] = silu_f(v[q]);
          store8bf(Cb + (size_t)row * 2048 + (col - 4096), v);
        }
      } else {
        if (col < 3072) {
          if (col < 2048) store8bf(Bb + (size_t)row * 2048 + col, v);
          else store8bf(Cb + (size_t)row * 2048 + (col - 2048), v);
          if (row < TP) {
            const int tt = row & 2047, b = row >> 11;
            if (tt >= 2045) store8f(out + O_CONVP + ((size_t)(b * 3 + tt - 2045) * 3072) + col, v);
            if ((row & 63) >= 61) store8bf(halo + ((size_t)((row >> 6) * 3 + (row & 63) - 61) * 3072) + col, v);
          } else {
            store8f(out + O_CONVS + ((size_t)((row - TP) * 3 + 2) * 3072) + col, v);
          }
        } else if (col < 4096) {
#pragma unroll
          for (int q = 0; q < 8; ++q) v[q] = silu_f(v[q]);
          store8bf(Cb + (size_t)row * 2048 + 1024 + (col - 3072), v);
        } else if (col == 4096) {
#pragma unroll
          for (int q = 0; q < 8; ++q) {
            const float x = v[q] + dt_bias[q];
            const float sp = (x > 20.f) ? x : log1pf(__expf(x));
            v[q] = -__expf(a_log[q]) * sp;
          }
          store8f(Gb + (size_t)row * 8, v);
        } else if (col == 4104) {
#pragma unroll
          for (int q = 0; q < 8; ++q) v[q] = 1.f / (1.f + __expf(-v[q]));
          store8f(Betab + (size_t)row * 8, v);
        }
      }
    };
    gemm_tile(smem, 16, aload, bload, epi);
  }
}

DI void phase_poolgrp(const Params& p, char* smem, int vb, int nb, int layer) {
  char* ws = p.ws;
  const u16* Wg = (const u16*)(ws + (layer == 0 ? W_0GRP : W_3GRP));
  const float* hist = p.in[layer == 0 ? 2 : 5];
  u16* Ab = (u16*)(ws + W_A);
  const u16* Bb = (const u16*)(ws + W_B);
  const u16* Cb = (const u16*)(ws + W_C);
  for (int t = vb; t < 129 * 16; t += nb) {
    const int mt = t >> 4, g = (t >> 2) & 3, nt = t & 3;
    const int w = 2 << g;
    const u16* Bp = Wg + (size_t)g * 512 * 512 + (size_t)nt * 128 * 512;
    auto aload = [&](int rl, int k) -> uint4 {
      const int row = mt * 128 + rl, c = g * 512 + k;
      const u16* xp = Bb + (size_t)row * 2048 + c;
      float x0[8], s[8];
      unpack8(*(const uint4*)xp, x0);
#pragma unroll
      for (int q = 0; q < 8; ++q) s[q] = x0[q];
      float inv;
      if (row < TP) {
        const int tt = row & 2047;
        const int lim = min(w - 1, tt);
        for (int j = 1; j <= lim; ++j) {
          float y[8];
          unpack8(*(const uint4*)(xp - (size_t)j * 2048), y);
#pragma unroll
          for (int q = 0; q < 8; ++q) s[q] += y[q];
        }
        inv = 1.f / (float)(lim + 1);
      } else {
        const float* hp = hist + ((size_t)(row - TP) * 15) * 2048 + c;
        for (int j = 1; j < w; ++j) {
          const f32x4 y0 = *(const f32x4*)(hp + (size_t)(15 - j) * 2048);
          const f32x4 y1 = *(const f32x4*)(hp + (size_t)(15 - j) * 2048 + 4);
#pragma unroll
          for (int q = 0; q < 4; ++q) { s[q] += y0[q]; s[4 + q] += y1[q]; }
        }
        inv = 1.f / (float)w;
      }
#pragma unroll
      for (int q = 0; q < 8; ++q) s[q] = s[q] * inv - x0[q];
      return pack8(s);
    };
    auto bload = [&](int r, int k) -> uint4 { return *(const uint4*)(Bp + (size_t)r * 512 + k); };
    auto epi = [&](int rl, int cl, const f32x4& v0, const f32x4& v1) {
      const int row = mt * 128 + rl, col = g * 512 + nt * 128 + cl;
      float z[8], v[8];
      unpack8(*(const uint4*)(Cb + (size_t)row * 2048 + col), z);
#pragma unroll
      for (int q = 0; q < 4; ++q) { v[q] = v0[q] * z[q]; v[4 + q] = v1[q] * z[4 + q]; }
      store8bf(Ab + (size_t)row * 2048 + col, v);
    };
    gemm_tile(smem, 8, aload, bload, epi);
  }
}

template <int KIND>
DI void phase_outproj(const Params& p, char* smem, int vb, int nb, int layer) {
  char* ws = p.ws;
  const u16* Wt = (const u16*)(ws + (layer == 0 ? W_0OUT : layer == 1 ? W_1OUT : layer == 2 ? W_2OUT : W_3OUT));
  constexpr int KD = (KIND == 0) ? 2048 : 1024;
  const u16* Ab = (const u16*)(ws + W_A);
  const u16* Cb = (const u16*)(ws + W_C);
  const float* oss = (const float*)(ws + W_STAT) + (size_t)7 * T;
  const float* ogain = p.in[23];
  u16* xb16 = (u16*)(p.out + O_DNS);
  float* xres = p.out + O_Y;
  float* sumsq_next = (float*)(ws + W_STAT) + (size_t)(layer + 1) * T;
  const float* xp = p.in[0];
  const float* xs = p.in[1];
  for (int t = vb; t < 129 * 8; t += nb) {
    const int mt = t >> 3, nt = t & 7;
    const u16* Bp = Wt + (size_t)nt * 128 * KD;
    auto aload = [&](int rl, int k) -> uint4 {
      const int row = mt * 128 + rl;
      if (KIND == 0) {
        return *(const uint4*)(Ab + (size_t)row * 2048 + k);
      } else {
        const int h = k >> 7;
        float o[8], z[8];
        unpack8(*(const uint4*)(Cb + (size_t)row * 2048 + k), o);
        unpack8(*(const uint4*)(Cb + (size_t)row * 2048 + 1024 + k), z);
        const float rs = rsqrtf(oss[(size_t)row * 8 + h] * (1.f / 128.f) + EPS);
        const f32x4 g0 = *(const f32x4*)(ogain + (k & 127));
        const f32x4 g1 = *(const f32x4*)(ogain + (k & 127) + 4);
#pragma unroll
        for (int q = 0; q < 4; ++q) { o[q] = o[q] * rs * g0[q] * z[q]; o[4 + q] = o[4 + q] * rs * g1[q] * z[4 + q]; }
        return pack8(o);
      }
    };
    auto bload = [&](int r, int k) -> uint4 { return *(const uint4*)(Bp + (size_t)r * KD + k); };
    auto epi = [&](int rl, int cl, const f32x4& v0, const f32x4& v1) {
      const int row = mt * 128 + rl, col = nt * 128 + cl;
      const float* xo = (layer == 0) ? ((row < TP) ? xp + (size_t)row * 1024 + col : xs + (size_t)(row - TP) * 1024 + col)
                                     : xres + (size_t)row * 1024 + col;
      const f32x4 x0 = *(const f32x4*)xo, x1 = *(const f32x4*)(xo + 4);
      float v[8];
      float ss = 0.f;
#pragma unroll
      for (int q = 0; q < 4; ++q) { v[q] = x0[q] + v0[q]; v[4 + q] = x1[q] + v1[q]; }
#pragma unroll
      for (int q = 0; q < 8; ++q) ss += v[q] * v[q];
      store8f(xres + (size_t)row * 1024 + col, v);
      if (layer < 3) store8bf(xb16 + (size_t)row * 1024 + col, v);
      ss = sum8(ss);
      if ((__lane_id() & 7) == 0) atomicAdd(&sumsq_next[row], ss);
    };
    gemm_tile(smem, KD / 64, aload, bload, epi);
  }
}

DI void phase_spatial(const Params& p, char* smem, int vb, int nb) {
  char* ws = p.ws;
  const u16* W16 = (const u16*)(ws + W_1WS);
  u16* Ab = (u16*)(ws + W_A);
  const u16* Bb = (const u16*)(ws + W_B);
  const u16* Cb = (const u16*)(ws + W_C);
  const float* lnstat = (const float*)(ws + W_STAT) + (size_t)5 * T;
  const float* ln_g = p.in[13];
  const float* ln_b = p.in[14];
  const float* wsf = p.in[15];
  const float* b_s = p.in[16];
  for (int t = vb; t < 128 * 16; t += nb) {
    const int mt = t >> 4, g = (t >> 2) & 3, nt = t & 3;
    const u16* Ap = W16 + (size_t)g * 128 * 128;
    auto aload = [&](int r, int k) -> uint4 { return *(const uint4*)(Ap + (size_t)r * 128 + k); };
    auto bload = [&](int nl, int k) -> uint4 {
      const int c = g * 512 + nt * 128 + nl;
      const float lg = ln_g[c], lb = ln_b[c];
      float o[8];
#pragma unroll
      for (int jj = 0; jj < 8; ++jj) {
        const int row = mt * 128 + k + jj;
        const float x = bf2f(Bb[(size_t)row * 2048 + c]);
        const float2 stt = *(const float2*)(lnstat + (size_t)row * 2);
        const float mu = stt.x * (1.f / 2048.f);
        const float var = stt.y * (1.f / 2048.f) - mu * mu;
        o[jj] = (x - mu) * rsqrtf(var + EPS) * lg + lb;
      }
      return pack8(o);
    };
    auto epi = [&](int rl, int cl, const f32x4& v0, const f32x4& v1) {
      const int row = mt * 128 + rl, col = g * 512 + nt * 128 + cl;
      const float bs = b_s[g * 128 + rl];
      float u[8], z[8], v[8];
      unpack8(*(const uint4*)(Ab + (size_t)row * 2048 + col), u);
      unpack8(*(const uint4*)(Cb + (size_t)row * 2048 + col), z);
#pragma unroll
      for (int q = 0; q < 4; ++q) { v[q] = (v0[q] + bs) * u[q] * z[q]; v[4 + q] = (v1[q] + bs) * u[4 + q] * z[4 + q]; }
      store8bf(Ab + (size_t)row * 2048 + col, v);
    };
    gemm_tile(smem, 2, aload, bload, epi);
  }
  const int gtid = vb * 256 + TID(), gn = nb * 256;
  for (int i = gtid; i < 128 * 256; i += gn) {
    const int b = i >> 8, c = (i & 255) * 8, row = TP + b, g = c >> 9;
    const float2 stt = *(const float2*)(lnstat + (size_t)row * 2);
    const float mu = stt.x * (1.f / 2048.f);
    const float rstd = rsqrtf(stt.y * (1.f / 2048.f) - mu * mu + EPS);
    const float w00 = wsf[(size_t)g * 128 * 128], bs = b_s[g * 128];
    float x[8], u[8], z[8], vn[8], o[8];
    unpack8(*(const uint4*)(Bb + (size_t)row * 2048 + c), x);
    unpack8(*(const uint4*)(Ab + (size_t)row * 2048 + c), u);
    unpack8(*(const uint4*)(Cb + (size_t)row * 2048 + c), z);
#pragma unroll
    for (int q = 0; q < 8; ++q) {
      vn[q] = (x[q] - mu) * rstd * ln_g[c + q] + ln_b[c + q];
      o[q] = (w00 * vn[q] + bs) * u[q] * z[q];
    }
    store8f(p.out + O_SGUV + (size_t)b * 2048 + c, vn);
    store8bf(Ab + (size_t)row * 2048 + c, o);
  }
}

DI void phase_chunkprep(const Params& p, char* smem, int vb, int nb) {
  char* ws = p.ws;
  const int tid = TID(), lane = tid & 63, wid = tid >> 6, fr = lane & 15, fq = lane >> 4;
  u16* Bb = (u16*)(ws + W_B);
  u16* Cb = (u16*)(ws + W_C);
  const u16* halo = (const u16*)(ws + W_A + A_HALO);
  u16* KTT = (u16*)(ws + W_A + A_KTT);
  u16* QK = (u16*)(ws + W_A + A_QK);
  const float* Gb = (const float*)(ws + W_G);
  const float* Betab = (const float*)(ws + W_BETA);
  float* alast = (float*)(ws + W_ALAST);
  const float* cw = p.in[20];
  u16* q_s = (u16*)smem;
  u16* k_s = q_s + 64 * 136;
  u16* v_s = k_s + 64 * 136;
  float* M_s = (float*)(smem + 3 * 64 * 136 * 2);
  float* gam_s = M_s + 4096;
  float* beta_s = gam_s + 64;
  float* eg_s = beta_s + 64;
  for (int it = vb; it < 2048; it += nb) {
    const int cgi = it >> 3, h = it & 7;
    const int row0 = cgi * 64;
    const bool has_prev = (cgi & 31) != 0;
    __syncthreads();
#pragma unroll 1
    for (int part = 0; part < 3; ++part) {
      const int ch = part * 1024 + h * 128 + 2 * lane;
      const u16* src = (part < 2) ? (Bb + part * 1024 + h * 128 + 2 * lane) : (Cb + h * 128 + 2 * lane);
      float c0[4], c1[4];
#pragma unroll
      for (int j = 0; j < 4; ++j) { c0[j] = cw[j * 3072 + ch]; c1[j] = cw[j * 3072 + ch + 1]; }
      const int i0 = 16 * wid;
      float xa[3], xb[3];
#pragma unroll
      for (int j = 0; j < 3; ++j) {
        unsigned u = 0;
        if (i0 > 0) u = *(const unsigned*)(src + (size_t)(row0 + i0 - 3 + j) * 2048);
        else if (has_prev) u = *(const unsigned*)(halo + ((size_t)((cgi - 1) * 3 + j) * 3072) + ch);
        xa[j] = __uint_as_float(u << 16); xb[j] = __uint_as_float(u & 0xffff0000u);
      }
      u16* dst = (part == 0) ? q_s : (part == 1 ? k_s : v_s);
#pragma unroll 4
      for (int r = 0; r < 16; ++r) {
        const unsigned u = *(const unsigned*)(src + (size_t)(row0 + i0 + r) * 2048);
        const float na = __uint_as_float(u << 16), nb2 = __uint_as_float(u & 0xffff0000u);
        float ya = xa[0] * c0[0] + xa[1] * c0[1] + xa[2] * c0[2] + na * c0[3];
        float yb = xb[0] * c1[0] + xb[1] * c1[1] + xb[2] * c1[2] + nb2 * c1[3];
        xa[0] = xa[1]; xa[1] = xa[2]; xa[2] = na;
        xb[0] = xb[1]; xb[1] = xb[2]; xb[2] = nb2;
        ya = silu_f(ya); yb = silu_f(yb);
        if (part < 2) {
          const float ss = wave_sum(ya * ya + yb * yb);
          const float sc = rsqrtf(ss + EPS) * (part == 0 ? 0.08838834764831845f : 1.f);
          ya *= sc; yb *= sc;
        }
        *(unsigned*)(dst + (i0 + r) * 136 + 2 * lane) = pack2(ya, yb);
      }
    }
    if (tid < 64) {
      float v = Gb[(size_t)(row0 + tid) * 8 + h];
#pragma unroll
      for (int d = 1; d < 64; d <<= 1) { const float tt = __shfl_up(v, d, 64); if (lane >= d) v += tt; }
      gam_s[tid] = v;
      eg_s[tid] = __expf(v);
      beta_s[tid] = Betab[(size_t)(row0 + tid) * 8 + h];
    }
    __syncthreads();
    {
      f32x4 kk[4], qk[4];
#pragma unroll
      for (int n = 0; n < 4; ++n) { kk[n] = f32x4{0.f, 0.f, 0.f, 0.f}; qk[n] = f32x4{0.f, 0.f, 0.f, 0.f}; }
#pragma unroll
      for (int ks = 0; ks < 4; ++ks) {
        const bf16x8 ak = *(const bf16x8*)(k_s + (16 * wid + fr) * 136 + ks * 32 + fq * 8);
        const bf16x8 aq = *(const bf16x8*)(q_s + (16 * wid + fr) * 136 + ks * 32 + fq * 8);
#pragma unroll
        for (int n = 0; n < 4; ++n) {
          const bf16x8 b = *(const bf16x8*)(k_s + (n * 16 + fr) * 136 + ks * 32 + fq * 8);
          kk[n] = __builtin_amdgcn_mfma_f32_16x16x32_bf16(ak, b, kk[n], 0, 0, 0);
          qk[n] = __builtin_amdgcn_mfma_f32_16x16x32_bf16(aq, b, qk[n], 0, 0, 0);
        }
      }
#pragma unroll
      for (int n = 0; n < 4; ++n)
#pragma unroll
        for (int j = 0; j < 4; ++j) {
          const int i = 16 * wid + fq * 4 + j, jc = n * 16 + fr;
          const float d = (i >= jc) ? __expf(gam_s[i] - gam_s[jc]) : 0.f;
          M_s[i * 64 + jc] = (i > jc) ? beta_s[i] * kk[n][j] * d : 0.f;
          QK[(size_t)it * 4096 + i * 64 + jc] = f2bf(qk[n][j] * d);
        }
    }
    __syncthreads();
    {
      const int col = tid;
      const bool isu = col < 128;
      const u16* rsrc = isu ? (v_s + col) : (k_s + (col - 128));
      u16* gdst = isu ? (Cb + (size_t)row0 * 2048 + h * 128 + col) : (Bb + (size_t)row0 * 2048 + 1024 + h * 128 + (col - 128));
      float sol[64];
#pragma unroll
      for (int i = 0; i < 64; ++i) {
        float a = beta_s[i] * bf2f(rsrc[i * 136]);
        if (!isu) a *= eg_s[i];
#pragma unroll
        for (int j = 0; j < i; ++j) a -= M_s[i * 64 + j] * sol[j];
        sol[i] = a;
        gdst[(size_t)i * 2048] = f2bf(a);
      }
    }
    for (int idx = tid; idx < 64 * 16; idx += 256) {
      const int i = idx >> 4, d8 = (idx & 15) * 8;
      float f[8];
      unpack8(*(const uint4*)(q_s + i * 136 + d8), f);
      const float e = eg_s[i];
#pragma unroll
      for (int q = 0; q < 8; ++q) f[q] *= e;
      store8bf(Bb + (size_t)(row0 + i) * 2048 + h * 128 + d8, f);
    }
    {
      const int d = tid & 127, half = tid >> 7;
      const float gl = gam_s[63];
#pragma unroll
      for (int i8 = 0; i8 < 4; ++i8) {
        const int ib = (half * 4 + i8) * 8;
        float f[8];
#pragma unroll
        for (int q = 0; q < 8; ++q) f[q] = bf2f(k_s[(ib + q) * 136 + d]) * __expf(gl - gam_s[ib + q]);
        store8bf(KTT + (size_t)it * 8192 + d * 64 + ib, f);
      }
      if (tid == 0) alast[it] = __expf(gl);
    }
  }

  const float* S0all = p.in[4];
  const float* chist = p.in[3];
  float* oss = (float*)(ws + W_STAT) + (size_t)7 * T;
  float* wss = (float*)(ws + W_WSS);
  float* kss = (float*)(ws + W_KSS);
  float* egs = (float*)(ws + W_EGS);
  float* qf = (float*)smem;
  float* kf = qf + 128;
  float* vf = kf + 128;
  float* red = vf + 128;
  for (int it = vb; it < 1024; it += nb) {
    const int b = it >> 3, h = it & 7, row = TP + b;
    __syncthreads();
    if (wid < 3) {
      const int part = wid;
      float y[2];
#pragma unroll
      for (int cc = 0; cc < 2; ++cc) {
        const int d = 2 * lane + cc;
        const int ch = part * 1024 + h * 128 + d;
        const float xn = (part < 2) ? bf2f(Bb[(size_t)row * 2048 + part * 1024 + h * 128 + d]) : bf2f(Cb[(size_t)row * 2048 + h * 128 + d]);
        float a = xn * cw[3 * 3072 + ch];
#pragma unroll
        for (int j = 0; j < 3; ++j) a += chist[((size_t)(b * 3 + j) * 3072) + ch] * cw[j * 3072 + ch];
        y[cc] = silu_f(a);
      }
      if (part < 2) {
        const float ss = wave_sum(y[0] * y[0] + y[1] * y[1]);
        const float sc = rsqrtf(ss + EPS) * (part == 0 ? 0.08838834764831845f : 1.f);
        y[0] *= sc; y[1] *= sc;
      }
      float* dst = (part == 0) ? qf : (part == 1 ? kf : vf);
      dst[2 * lane] = y[0]; dst[2 * lane + 1] = y[1];
    }
    __syncthreads();
    const float g = Gb[(size_t)row * 8 + h], beta = Betab[(size_t)row * 8 + h];
    const float eg = __expf(g);
    const float* S0 = S0all + (size_t)it * 16384;
    {
      const int c4 = tid & 31, rg = tid >> 5;
      float ks[4] = {0.f, 0.f, 0.f, 0.f}, qs[4] = {0.f, 0.f, 0.f, 0.f};
#pragma unroll 4
      for (int r = 0; r < 16; ++r) {
        const int dk = rg * 16 + r;
        const f32x4 s = *(const f32x4*)(S0 + dk * 128 + c4 * 4);
        const float kv = kf[dk], qv = qf[dk];
#pragma unroll
        for (int e = 0; e < 4; ++e) { ks[e] += kv * s[e]; qs[e] += qv * s[e]; }
      }
#pragma unroll
      for (int e = 0; e < 4; ++e) { red[rg * 128 + c4 * 4 + e] = ks[e]; red[1024 + rg * 128 + c4 * 4 + e] = qs[e]; }
    }
    const float qkdot = wave_sum(qf[lane] * kf[lane] + qf[lane + 64] * kf[lane + 64]);
    __syncthreads();
    if (tid < 128) {
      const int dv = tid;
      float kS = 0.f, qS = 0.f;
#pragma unroll
      for (int rg = 0; rg < 8; ++rg) { kS += red[rg * 128 + dv]; qS += red[1024 + rg * 128 + dv]; }
      const float w = beta * (vf[dv] - eg * kS);
      const float o = eg * qS + qkdot * w;
      Cb[(size_t)row * 2048 + h * 128 + dv] = f2bf(o);
      wss[(size_t)it * 128 + dv] = w;
      kss[(size_t)it * 128 + dv] = kf[dv];
      const float s2 = wave_sum(o * o);
      if (lane == 0) atomicAdd(&oss[(size_t)row * 8 + h], s2);
      if (tid == 0) egs[it] = eg;
    }
  }
}

DI void phase_scan(const Params& p, char* smem, int vb, int nb) {
  char* ws = p.ws;
  const int tid = TID(), lane = tid & 63, wid = tid >> 6, fr = lane & 15, fq = lane >> 4;
  const u16* Bb = (const u16*)(ws + W_B);
  u16* Cb = (u16*)(ws + W_C);
  const u16* KTT = (const u16*)(ws + W_A + A_KTT);
  const u16* QK = (const u16*)(ws + W_A + A_QK);
  const float* alast = (const float*)(ws + W_ALAST);
  float* oss = (float*)(ws + W_STAT) + (size_t)7 * T;
  u16* ST = (u16*)smem;
  u16* WT = ST + 32 * 136;
  for (int it = vb; it < 256; it += nb) {
    const int b = it >> 5, h = (it >> 2) & 7, sl = it & 3;
    f32x4 S[2][2];
#pragma unroll
    for (int mi = 0; mi < 2; ++mi)
#pragma unroll
      for (int ni = 0; ni < 2; ++ni) S[mi][ni] = f32x4{0.f, 0.f, 0.f, 0.f};
    __syncthreads();
    for (int i = tid; i < 32 * 136 / 2; i += 256) ((unsigned*)ST)[i] = 0u;
    __syncthreads();
#pragma unroll 1
    for (int n = 0; n < 32; ++n) {
      const int cgi = b * 32 + n, item8 = cgi * 8 + h, row0 = cgi * 64;
      const float al = alast[item8];
      const u16* wkp = Bb + (size_t)(row0 + 16 * wid + fr) * 2048 + 1024 + h * 128 + fq * 8;
      const u16* qdp = Bb + (size_t)(row0 + 16 * wid + fr) * 2048 + h * 128 + fq * 8;
      bf16x8 awk[4], aqd[4], aqk[2], akt[2][2];
#pragma unroll
      for (int ks = 0; ks < 4; ++ks) { awk[ks] = *(const bf16x8*)(wkp + ks * 32); aqd[ks] = *(const bf16x8*)(qdp + ks * 32); }
#pragma unroll
      for (int ks = 0; ks < 2; ++ks) aqk[ks] = *(const bf16x8*)(QK + (size_t)item8 * 4096 + (16 * wid + fr) * 64 + ks * 32 + fq * 8);
#pragma unroll
      for (int mi = 0; mi < 2; ++mi)
#pragma unroll
        for (int ks = 0; ks < 2; ++ks)
          akt[mi][ks] = *(const bf16x8*)(KTT + (size_t)item8 * 8192 + ((2 * wid + mi) * 16 + fr) * 64 + ks * 32 + fq * 8);
      u16* up = Cb + (size_t)(row0 + 16 * wid + fq * 4) * 2048 + h * 128 + sl * 32 + fr;
      float uu[2][4];
#pragma unroll
      for (int ni = 0; ni < 2; ++ni)
#pragma unroll
        for (int j = 0; j < 4; ++j) uu[ni][j] = bf2f(up[(size_t)j * 2048 + ni * 16]);
      bf16x8 bs[2][4];
#pragma unroll
      for (int ni = 0; ni < 2; ++ni)
#pragma unroll
        for (int ks = 0; ks < 4; ++ks) bs[ni][ks] = *(const bf16x8*)(ST + (ni * 16 + fr) * 136 + ks * 32 + fq * 8);
      f32x4 aw[2] = {f32x4{0.f, 0.f, 0.f, 0.f}, f32x4{0.f, 0.f, 0.f, 0.f}};
#pragma unroll
      for (int ks = 0; ks < 4; ++ks)
#pragma unroll
        for (int ni = 0; ni < 2; ++ni) aw[ni] = __builtin_amdgcn_mfma_f32_16x16x32_bf16(awk[ks], bs[ni][ks], aw[ni], 0, 0, 0);
#pragma unroll
      for (int ni = 0; ni < 2; ++ni) {
        uint2 pk;
        pk.x = pack2(uu[ni][0] - aw[ni][0], uu[ni][1] - aw[ni][1]);
        pk.y = pack2(uu[ni][2] - aw[ni][2], uu[ni][3] - aw[ni][3]);
        *(uint2*)(WT + (ni * 16 + fr) * 72 + 16 * wid + fq * 4) = pk;
      }
      __syncthreads();
      bf16x8 bw[2][2];
#pragma unroll
      for (int ni = 0; ni < 2; ++ni)
#pragma unroll
        for (int ks = 0; ks < 2; ++ks) bw[ni][ks] = *(const bf16x8*)(WT + (ni * 16 + fr) * 72 + ks * 32 + fq * 8);
      f32x4 ao[2] = {f32x4{0.f, 0.f, 0.f, 0.f}, f32x4{0.f, 0.f, 0.f, 0.f}};
#pragma unroll
      for (int ni = 0; ni < 2; ++ni) {
#pragma unroll
        for (int ks = 0; ks < 4; ++ks) ao[ni] = __builtin_amdgcn_mfma_f32_16x16x32_bf16(aqd[ks], bs[ni][ks], ao[ni], 0, 0, 0);
#pragma unroll
        for (int ks = 0; ks < 2; ++ks) ao[ni] = __builtin_amdgcn_mfma_f32_16x16x32_bf16(aqk[ks], bw[ni][ks], ao[ni], 0, 0, 0);
      }
#pragma unroll
      for (int j = 0; j < 4; ++j) {
        float s2 = ao[0][j] * ao[0][j] + ao[1][j] * ao[1][j];
        s2 = sum16(s2);
        if (fr == 0) atomicAdd(&oss[(size_t)(row0 + 16 * wid + fq * 4 + j) * 8 + h], s2);
#pragma unroll
        for (int ni = 0; ni < 2; ++ni) up[(size_t)j * 2048 + ni * 16] = f2bf(ao[ni][j]);
      }
#pragma unroll
      for (int mi = 0; mi < 2; ++mi)
#pragma unroll
        for (int ni = 0; ni < 2; ++ni) {
          S[mi][ni] = S[mi][ni] * al;
#pragma unroll
          for (int ks = 0; ks < 2; ++ks) S[mi][ni] = __builtin_amdgcn_mfma_f32_16x16x32_bf16(akt[mi][ks], bw[ni][ks], S[mi][ni], 0, 0, 0);
          uint2 pk;
          pk.x = pack2(S[mi][ni][0], S[mi][ni][1]);
          pk.y = pack2(S[mi][ni][2], S[mi][ni][3]);
          *(uint2*)(ST + (ni * 16 + fr) * 136 + (2 * wid + mi) * 16 + fq * 4) = pk;
        }
      __syncthreads();
    }
    float* dst = p.out + O_DNP + (size_t)(b * 8 + h) * 16384;
#pragma unroll
    for (int mi = 0; mi < 2; ++mi)
#pragma unroll
      for (int ni = 0; ni < 2; ++ni)
#pragma unroll
        for (int j = 0; j < 4; ++j) dst[((2 * wid + mi) * 16 + fq * 4 + j) * 128 + sl * 32 + ni * 16 + fr] = S[mi][ni][j];
  }
}

DI void phase_final(const Params& p, int vb, int nb) {
  char* ws = p.ws;
  const int gtid = vb * 256 + TID(), gn = nb * 256;
  const float* sumsq = (const float*)(ws + W_STAT) + (size_t)4 * T;
  const float* gain = p.in[30];
  float* y = p.out + O_Y;
  for (int i = gtid; i < T * 256; i += gn) {
    const int row = i >> 8, c = (i & 255) * 4;
    const float rs = rsqrtf(sumsq[row] * (1.f / 1024.f) + EPS);
    f32x4 v = *(const f32x4*)(y + (size_t)row * 1024 + c);
    const f32x4 g = *(const f32x4*)(gain + c);
#pragma unroll
    for (int q = 0; q < 4; ++q) v[q] = v[q] * rs * g[q];
    *(f32x4*)(y + (size_t)row * 1024 + c) = v;
  }
  const float* S0 = p.in[4];
  const float* wss = (const float*)(ws + W_WSS);
  const float* kss = (const float*)(ws + W_KSS);
  const float* egs = (const float*)(ws + W_EGS);
  float* dS = p.out + O_DNS;
  for (int i = gtid; i < 1024 * 4096; i += gn) {
    const int it = i >> 12, dk = (i >> 5) & 127, dv = (i & 31) * 4;
    const float eg = egs[it], kv = kss[it * 128 + dk];
    const f32x4 s = *(const f32x4*)(S0 + (size_t)i * 4);
    const f32x4 w = *(const f32x4*)(wss + it * 128 + dv);
    f32x4 o;
#pragma unroll
    for (int q = 0; q < 4; ++q) o[q] = eg * s[q] + kv * w[q];
    *(f32x4*)(dS + (size_t)i * 4) = o;
  }
}

__global__ void __launch_bounds__(256, 2) mega(Params p, int ph_lo, int ph_hi, int coop) {
  __shared__ __attribute__((aligned(16))) char smem[LDS_BYTES];
  const int nb = gridDim.x;
  const int bid = blockIdx.x;
  const int vb = ((nb & 7) == 0) ? ((bid & 7) * (nb >> 3) + (bid >> 3)) : bid;
#pragma unroll 1
  for (int ph = ph_lo; ph < ph_hi; ++ph) {
    Params q = p;
    int vbl = vb, nbl = nb;
    asm volatile("" : "+s"(q.ws), "+s"(q.out), "+s"(vbl), "+s"(nbl));
    switch (ph) {
      case 0: if (PH_MASK & (1 << 0)) phase_prep(q, smem, vbl, nbl); break;
      case 1: if (PH_MASK & (1 << 1)) phase_inproj<0>(q, smem, vbl, nbl, 0); break;
      case 2: if (PH_MASK & (1 << 2)) phase_poolgrp(q, smem, vbl, nbl, 0); break;
      case 3: if (PH_MASK & (1 << 3)) phase_outproj<0>(q, smem, vbl, nbl, 0); break;
      case 4: if (PH_MASK & (1 << 4)) phase_inproj<1>(q, smem, vbl, nbl, 1); break;
      case 5: if (PH_MASK & (1 << 5)) phase_spatial(q, smem, vbl, nbl); break;
      case 6: if (PH_MASK & (1 << 6)) phase_outproj<0>(q, smem, vbl, nbl, 1); break;
      case 7: if (PH_MASK & (1 << 7)) phase_inproj<2>(q, smem, vbl, nbl, 2); break;
      case 8: if (PH_MASK & (1 << 8)) phase_chunkprep(q, smem, vbl, nbl); break;
      case 9: if (PH_MASK & (1 << 9)) phase_scan(q, smem, vbl, nbl); break;
      case 10: if (PH_MASK & (1 << 10)) phase_outproj<1>(q, smem, vbl, nbl, 2); break;
      case 11: if (PH_MASK & (1 << 11)) phase_inproj<0>(q, smem, vbl, nbl, 3); break;
      case 12: if (PH_MASK & (1 << 12)) phase_poolgrp(q, smem, vbl, nbl, 3); break;
      case 13: if (PH_MASK & (1 << 13)) phase_outproj<0>(q, smem, vbl, nbl, 3); break;
      case 14: if (PH_MASK & (1 << 14)) phase_final(q, vbl, nbl); break;
      default: break;
    }
    if (coop && ph + 1 < ph_hi) cg::this_grid().sync();
  }
}

extern "C" void kernel_launch(void* const* d_in, const int* in_sizes, int n_in, void* d_out, int out_size, void* d_ws,
                              size_t ws_size, hipStream_t stream) {
  static int grid_blocks = 0;
  if (!grid_blocks) {
    int dev = 0, cus = 0, per_cu = 0;
    hipGetDevice(&dev);
    hipDeviceGetAttribute(&cus, hipDeviceAttributeMultiprocessorCount, dev);
    hipOccupancyMaxActiveBlocksPerMultiprocessor(&per_cu, mega, 256, 0);
    if (per_cu < 1) per_cu = 1;
    if (per_cu > 2) per_cu = 2;
    grid_blocks = cus * per_cu;
  }
  Params p{};
  for (int i = 0; i < 31; ++i) p.in[i] = (const float*)d_in[i];
  p.out = (float*)d_out;
  p.ws = (char*)d_ws;
  if (ws_size < W_END) { fprintf(stderr, "workspace too small: %zu < %zu\n", ws_size, (size_t)W_END); }
#if MULTI_LAUNCH
  for (int ph = 0; ph < NPHASE; ++ph) {
    hipLaunchKernelGGL(mega, dim3(grid_blocks), dim3(256), 0, stream, p, ph, ph + 1, 0);
  }
#else
  int lo = 0, hi = NPHASE, coop = 1;
  void* args[] = {&p, &lo, &hi, &coop};
  hipError_t e = hipLaunchCooperativeKernel((void*)mega, dim3(grid_blocks), dim3(256), args, 0, stream);
  if (e != hipSuccess) fprintf(stderr, "cooperative launch failed: %s (grid %d)\n", hipGetErrorString(e), grid_blocks);
#endif
}
```

```cpp
#include <hip/hip_runtime.h>
#include <hip/hip_cooperative_groups.h>
#include <cstdio>
namespace cg = cooperative_groups;

#ifndef PH_MASK
#define PH_MASK 0x7fff
#endif
#ifndef MULTI_LAUNCH
#define MULTI_LAUNCH 0
#endif

typedef unsigned short u16;
using bf16x8 = __attribute__((ext_vector_type(8))) short;
using f32x4 = __attribute__((ext_vector_type(4))) float;
#define DI __device__ __forceinline__

constexpr int T = 16512;
constexpr int TP = 16384;
constexpr float EPS = 1e-6f;
constexpr int NPHASE = 15;
constexpr int LDS_BYTES = 73728;

constexpr size_t O_Y = 0;
constexpr size_t O_POOL0P = (size_t)T * 1024;
constexpr size_t O_POOL0S = O_POOL0P + 8 * 15 * 2048;
constexpr size_t O_SGUV = O_POOL0S + 128 * 15 * 2048;
constexpr size_t O_CONVP = O_SGUV + 128 * 2048;
constexpr size_t O_CONVS = O_CONVP + 8 * 3 * 3072;
constexpr size_t O_DNP = O_CONVS + 128 * 3 * 3072;
constexpr size_t O_DNS = O_DNP + 8 * 8 * 128 * 128;
constexpr size_t O_POOL3P = O_DNS + (size_t)128 * 8 * 128 * 128;
constexpr size_t O_POOL3S = O_POOL3P + 8 * 15 * 2048;

constexpr size_t W_0IN = 0;
constexpr size_t W_0GRP = W_0IN + (size_t)4096 * 1024 * 2;
constexpr size_t W_0OUT = W_0GRP + (size_t)4 * 512 * 512 * 2;
constexpr size_t W_1IN = W_0OUT + (size_t)1024 * 2048 * 2;
constexpr size_t W_1WS = W_1IN + (size_t)6144 * 1024 * 2;
constexpr size_t W_1OUT = W_1WS + (size_t)4 * 128 * 128 * 2;
constexpr size_t W_2IN = W_1OUT + (size_t)1024 * 2048 * 2;
constexpr size_t W_2OUT = W_2IN + (size_t)4224 * 1024 * 2;
constexpr size_t W_3IN = W_2OUT + (size_t)1024 * 1024 * 2;
constexpr size_t W_3GRP = W_3IN + (size_t)4096 * 1024 * 2;
constexpr size_t W_3OUT = W_3GRP + (size_t)4 * 512 * 512 * 2;
constexpr size_t W_A = W_3OUT + (size_t)1024 * 2048 * 2;
constexpr size_t ABC = (size_t)T * 2048 * 2;
constexpr size_t W_B = W_A + ABC;
constexpr size_t W_C = W_B + ABC;
constexpr size_t W_STAT = W_C + ABC;
constexpr size_t W_G = W_STAT + (size_t)15 * T * 4;
constexpr size_t W_BETA = W_G + (size_t)T * 8 * 4;
constexpr size_t W_ALAST = W_BETA + (size_t)T * 8 * 4;
constexpr size_t W_WSS = W_ALAST + 2048 * 4;
constexpr size_t W_KSS = W_WSS + 128 * 8 * 128 * 4;
constexpr size_t W_EGS = W_KSS + 128 * 8 * 128 * 4;
constexpr size_t W_END = W_EGS + 128 * 8 * 4;
constexpr size_t A_HALO = 0;
constexpr size_t A_KTT = A_HALO + (size_t)256 * 3 * 3072 * 2;
constexpr size_t A_QK = A_KTT + (size_t)2048 * 8192 * 2;

struct Params {
  const float* in[31];
  float* out;
  char* ws;
};

DI int TID() { int t = threadIdx.x; asm volatile("" : "+v"(t)); return t; }
DI float bf2f(u16 x) { return __uint_as_float(((unsigned)x) << 16); }
typedef __bf16 bf16v2_t __attribute__((ext_vector_type(2)));
typedef float f32v2_t __attribute__((ext_vector_type(2)));
DI unsigned pack2(float a, float b) {
  f32v2_t f = {a, b};
  bf16v2_t h = __builtin_convertvector(f, bf16v2_t);
  return __builtin_bit_cast(unsigned, h);
}
DI u16 f2bf(float x) { return (u16)(pack2(x, 0.f) & 0xffffu); }
DI void unpack8(const uint4& u, float* f) {
  f[0] = __uint_as_float(u.x << 16); f[1] = __uint_as_float(u.x & 0xffff0000u);
  f[2] = __uint_as_float(u.y << 16); f[3] = __uint_as_float(u.y & 0xffff0000u);
  f[4] = __uint_as_float(u.z << 16); f[5] = __uint_as_float(u.z & 0xffff0000u);
  f[6] = __uint_as_float(u.w << 16); f[7] = __uint_as_float(u.w & 0xffff0000u);
}
DI uint4 pack8(const float* f) {
  uint4 u;
  u.x = pack2(f[0], f[1]); u.y = pack2(f[2], f[3]); u.z = pack2(f[4], f[5]); u.w = pack2(f[6], f[7]);
  return u;
}
DI float silu_f(float x) { return x / (1.f + __expf(-x)); }
DI float gelu_f(float x) { return 0.5f * x * (1.f + erff(x * 0.70710678118654752f)); }
DI float wave_sum(float v) {
#pragma unroll
  for (int o = 32; o > 0; o >>= 1) v += __shfl_xor(v, o, 64);
  return v;
}
DI float sum8(float v) {
  v += __shfl_xor(v, 1, 64); v += __shfl_xor(v, 2, 64); v += __shfl_xor(v, 4, 64);
  return v;
}
DI float sum16(float v) {
  v += __shfl_xor(v, 1, 64); v += __shfl_xor(v, 2, 64); v += __shfl_xor(v, 4, 64); v += __shfl_xor(v, 8, 64);
  return v;
}

template <class AL, class BL, class EP>
DI void gemm_tile(char* smem, int nk, AL aload, BL bload, EP epi) {
  const int tid = TID(), lane = tid & 63, wid = tid >> 6;
  const int wr = wid >> 1, wc = wid & 1, fr = lane & 15, fq = lane >> 4;
  f32x4 acc[4][4];
#pragma unroll
  for (int m = 0; m < 4; ++m)
#pragma unroll
    for (int n = 0; n < 4; ++n) acc[m][n] = f32x4{0.f, 0.f, 0.f, 0.f};
  const int crow = tid >> 3, ck = (tid & 7) * 8;
  uint4 ra[4], rb[4];
#pragma unroll
  for (int i = 0; i < 4; ++i) { ra[i] = aload(crow + 32 * i, ck); rb[i] = bload(crow + 32 * i, ck); }
  __syncthreads();
#pragma unroll
  for (int i = 0; i < 4; ++i) {
    *(uint4*)(smem + (crow + 32 * i) * 144 + ck * 2) = ra[i];
    *(uint4*)(smem + 18432 + (crow + 32 * i) * 144 + ck * 2) = rb[i];
  }
  __syncthreads();
  for (int kt = 0; kt < nk; ++kt) {
    const int cur = kt & 1;
    const bool more = (kt + 1 < nk);
    if (more) {
#pragma unroll
      for (int i = 0; i < 4; ++i) { ra[i] = aload(crow + 32 * i, (kt + 1) * 64 + ck); rb[i] = bload(crow + 32 * i, (kt + 1) * 64 + ck); }
    }
    const char* As = smem + cur * 36864;
    const char* Bs = As + 18432;
#pragma unroll
    for (int ks = 0; ks < 2; ++ks) {
      bf16x8 a[4], b[4];
#pragma unroll
      for (int m = 0; m < 4; ++m) a[m] = *(const bf16x8*)(As + (wr * 64 + m * 16 + fr) * 144 + ks * 64 + fq * 16);
#pragma unroll
      for (int n = 0; n < 4; ++n) b[n] = *(const bf16x8*)(Bs + (wc * 64 + n * 16 + fr) * 144 + ks * 64 + fq * 16);
#pragma unroll
      for (int m = 0; m < 4; ++m)
#pragma unroll
        for (int n = 0; n < 4; ++n) acc[m][n] = __builtin_amdgcn_mfma_f32_16x16x32_bf16(a[m], b[n], acc[m][n], 0, 0, 0);
    }
    if (more) {
      char* Ad = smem + (cur ^ 1) * 36864;
#pragma unroll
      for (int i = 0; i < 4; ++i) {
        *(uint4*)(Ad + (crow + 32 * i) * 144 + ck * 2) = ra[i];
        *(uint4*)(Ad + 18432 + (crow + 32 * i) * 144 + ck * 2) = rb[i];
      }
    }
    __syncthreads();
  }
  float* st = (float*)(smem + wid * 17408);
#pragma unroll
  for (int m = 0; m < 4; ++m)
#pragma unroll
    for (int n = 0; n < 4; ++n)
#pragma unroll
      for (int j = 0; j < 4; ++j) st[(m * 16 + fq * 4 + j) * 68 + n * 16 + fr] = acc[m][n][j];
  __syncthreads();
#pragma unroll 1
  for (int i = 0; i < 8; ++i) {
    const int r = (lane >> 3) + 8 * i, c = (lane & 7) * 8;
    f32x4 v0 = *(const f32x4*)(st + r * 68 + c);
    f32x4 v1 = *(const f32x4*)(st + r * 68 + c + 4);
    epi(wr * 64 + r, wc * 64 + c, v0, v1);
  }
}

DI void store8bf(u16* dst, const float* v) { *(uint4*)dst = pack8(v); }
DI void store8f(float* dst, const float* v) {
  *(f32x4*)dst = f32x4{v[0], v[1], v[2], v[3]};
  *(f32x4*)(dst + 4) = f32x4{v[4], v[5], v[6], v[7]};
}

DI void transpose_job(char* smem, const float* W, int K, int N, int Npad, const float* kgain, const float* nscale,
                      u16* Wt, int vb, int nb) {
  const int tid = TID();
  const int tk = K / 64, tn = Npad / 64;
  float* tile = (float*)smem;
  for (int t = vb; t < tk * tn; t += nb) {
    const int k0 = (t % tk) * 64, n0 = (t / tk) * 64;
    __syncthreads();
    {
      const int nn = tid & 63, n = n0 + nn;
      const float ns = (nscale && n < N) ? nscale[n] : 1.f;
#pragma unroll 4
      for (int i = 0; i < 16; ++i) {
        const int kk = (tid >> 6) + 4 * i;
        float v = (n < N) ? W[(size_t)(k0 + kk) * N + n] : 0.f;
        if (kgain) v *= kgain[k0 + kk];
        tile[kk * 65 + nn] = v * ns;
      }
    }
    __syncthreads();
    {
      const int nn = tid >> 2, kc = (tid & 3) * 16;
      float f[16];
#pragma unroll
      for (int q = 0; q < 16; ++q) f[q] = tile[(kc + q) * 65 + nn];
      u16* dst = Wt + (size_t)(n0 + nn) * K + k0 + kc;
      *(uint4*)dst = pack8(f);
      *(uint4*)(dst + 8) = pack8(f + 8);
    }
  }
}

DI void phase_prep(const Params& p, char* smem, int vb, int nb) {
  char* ws = p.ws;
  transpose_job(smem, p.in[7], 1024, 4096, 4096, p.in[6], nullptr, (u16*)(ws + W_0IN), vb, nb);
  for (int g = 0; g < 4; ++g)
    transpose_job(smem, p.in[8] + (size_t)g * 512 * 512, 512, 512, 512, nullptr, p.in[9] + g * 512,
                  (u16*)(ws + W_0GRP) + (size_t)g * 512 * 512, vb, nb);
  transpose_job(smem, p.in[10], 2048, 1024, 1024, nullptr, nullptr, (u16*)(ws + W_0OUT), vb, nb);
  transpose_job(smem, p.in[12], 1024, 6144, 6144, p.in[11], nullptr, (u16*)(ws + W_1IN), vb, nb);
  transpose_job(smem, p.in[17], 2048, 1024, 1024, nullptr, nullptr, (u16*)(ws + W_1OUT), vb, nb);
  transpose_job(smem, p.in[19], 1024, 4112, 4224, p.in[18], nullptr, (u16*)(ws + W_2IN), vb, nb);
  transpose_job(smem, p.in[24], 1024, 1024, 1024, nullptr, nullptr, (u16*)(ws + W_2OUT), vb, nb);
  transpose_job(smem, p.in[26], 1024, 4096, 4096, p.in[25], nullptr, (u16*)(ws + W_3IN), vb, nb);
  for (int g = 0; g < 4; ++g)
    transpose_job(smem, p.in[27] + (size_t)g * 512 * 512, 512, 512, 512, nullptr, p.in[28] + g * 512,
                  (u16*)(ws + W_3GRP) + (size_t)g * 512 * 512, vb, nb);
  transpose_job(smem, p.in[29], 2048, 1024, 1024, nullptr, nullptr, (u16*)(ws + W_3OUT), vb, nb);

  const int gtid = vb * 256 + TID(), gn = nb * 256;
  {
    u16* w16 = (u16*)(ws + W_1WS);
    const float* wsf = p.in[15];
    for (int i = gtid; i < 4 * 128 * 128; i += gn) {
      const int jj = i & 127, ii = (i >> 7) & 127;
      w16[i] = (jj <= ii) ? f2bf(wsf[i]) : (u16)0;
    }
  }
  {
    float* st = (float*)(ws + W_STAT);
    for (int i = T + gtid; i < 15 * T; i += gn) st[i] = 0.f;
  }
  {
    u16* xb16 = (u16*)(p.out + O_DNS);
    float* sumsq = (float*)(ws + W_STAT);
    const int lane = gtid & 63;
    const int gw = gtid >> 6, nw = gn >> 6;
    for (int row = gw; row < T; row += nw) {
      const float* src = (row < TP) ? p.in[0] + (size_t)row * 1024 : p.in[1] + (size_t)(row - TP) * 1024;
      float s = 0.f;
#pragma unroll
      for (int i = 0; i < 4; ++i) {
        const int c = (lane + 64 * i) * 4;
        f32x4 v = *(const f32x4*)(src + c);
        s += v[0] * v[0] + v[1] * v[1] + v[2] * v[2] + v[3] * v[3];
        uint2 o; o.x = pack2(v[0], v[1]); o.y = pack2(v[2], v[3]);
        *(uint2*)(xb16 + (size_t)row * 1024 + c) = o;
      }
      s = wave_sum(s);
      if (lane == 0) sumsq[row] = s;
    }
  }
  for (int i = gtid; i < 128 * 14 * 512; i += gn) {
    const int c4 = i & 511, r = (i >> 9) % 14, b = i / (14 * 512);
    const size_t so = ((size_t)(b * 15 + r + 1) * 2048) + c4 * 4, dof = ((size_t)(b * 15 + r) * 2048) + c4 * 4;
    *(f32x4*)(p.out + O_POOL0S + dof) = *(const f32x4*)(p.in[2] + so);
    *(f32x4*)(p.out + O_POOL3S + dof) = *(const f32x4*)(p.in[5] + so);
  }
  for (int i = gtid; i < 128 * 2 * 768; i += gn) {
    const int c4 = i % 768, r = (i / 768) & 1, b = i / (2 * 768);
    *(f32x4*)(p.out + O_CONVS + ((size_t)(b * 3 + r) * 3072) + c4 * 4) =
        *(const f32x4*)(p.in[3] + ((size_t)(b * 3 + r + 1) * 3072) + c4 * 4);
  }
}

template <int KIND>
DI void phase_inproj(const Params& p, char* smem, int vb, int nb, int layer) {
  char* ws = p.ws;
  constexpr int NT = (KIND == 0) ? 32 : (KIND == 1 ? 48 : 33);
  const u16* Wt = (const u16*)(ws + (layer == 0 ? W_0IN : layer == 1 ? W_1IN : layer == 2 ? W_2IN : W_3IN));
  const u16* xb16 = (const u16*)(p.out + O_DNS);
  const float* sumsq = (const float*)(ws + W_STAT) + (size_t)layer * T;
  u16* Ab = (u16*)(ws + W_A);
  u16* Bb = (u16*)(ws + W_B);
  u16* Cb = (u16*)(ws + W_C);
  float* lnstat = (float*)(ws + W_STAT) + (size_t)5 * T;
  float* Gb = (float*)(ws + W_G);
  float* Betab = (float*)(ws + W_BETA);
  u16* halo = (u16*)(ws + W_A + A_HALO);
  float* out = p.out;
  const float* a_log = p.in[21];
  const float* dt_bias = p.in[22];
  const size_t o_poolp = (layer == 0) ? O_POOL0P : O_POOL3P;
  const size_t o_pools = (layer == 0) ? O_POOL0S : O_POOL3S;
  for (int t = vb; t < 129 * NT; t += nb) {
    const int mt = t / NT, nt = t % NT;
    const u16* Ap = xb16 + (size_t)mt * 128 * 1024;
    const u16* Bp = Wt + (size_t)nt * 128 * 1024;
    auto aload = [&](int r, int k) -> uint4 { return *(const uint4*)(Ap + (size_t)r * 1024 + k); };
    auto bload = [&](int r, int k) -> uint4 { return *(const uint4*)(Bp + (size_t)r * 1024 + k); };
    auto epi = [&](int rl, int cl, const f32x4& v0, const f32x4& v1) {
      const int row = mt * 128 + rl, col = nt * 128 + cl;
      const float rs = rsqrtf(sumsq[row] * (1.f / 1024.f) + EPS);
      float v[8];
#pragma unroll
      for (int q = 0; q < 4; ++q) { v[q] = v0[q] * rs; v[4 + q] = v1[q] * rs; }
      if (KIND == 0) {
        if (col < 2048) {
          store8bf(Bb + (size_t)row * 2048 + col, v);
          if (row < TP) {
            const int tt = row & 2047, b = row >> 11;
            if (tt >= 2033) store8f(out + o_poolp + ((size_t)(b * 15 + tt - 2033) * 2048) + col, v);
          } else {
            store8f(out + o_pools + ((size_t)((row - TP) * 15 + 14) * 2048) + col, v);
          }
        } else {
#pragma unroll
          for (int q = 0; q < 8; ++q) v[q] = silu_f(v[q]);
          store8bf(Cb + (size_t)row * 2048 + (col - 2048), v);
        }
      } else if (KIND == 1) {
        if (col < 2048) {
#pragma unroll
          for (int q = 0; q < 8; ++q) v[q] = gelu_f(v[q]);
          store8bf(Ab + (size_t)row * 2048 + col, v);
        } else if (col < 4096) {
          float s1 = 0.f, s2 = 0.f;
#pragma unroll
          for (int q = 0; q < 8; ++q) { v[q] = gelu_f(v[q]); s1 += v[q]; s2 += v[q] * v[q]; }
          store8bf(Bb + (size_t)row * 2048 + (col - 2048), v);
          s1 = sum8(s1); s2 = sum8(s2);
          if ((__lane_id() & 7) == 0) { atomicAdd(&lnstat[row * 2], s1); atomicAdd(&lnstat[row * 2 + 1], s2); }
        } else {
#pragma unroll
          for (int q = 0; q < 8; ++q) v[q] = silu_f(v[q]);
          store8bf(Cb + (size_t)row * 2048 + (col - 4096), v);
        }
      } else {
        if (col < 3072) {
          if (col < 2048) store8bf(Bb + (size_t)row * 2048 + col, v);
          else store8bf(Cb + (size_t)row * 2048 + (col - 2048), v);
          if (row < TP) {
            const int tt = row & 2047, b = row >> 11;
            if (tt >= 2045) store8f(out + O_CONVP + ((size_t)(b * 3 + tt - 2045) * 3072) + col, v);
            if ((row & 63) >= 61) store8bf(halo + ((size_t)((row >> 6) * 3 + (row & 63) - 61) * 3072) + col, v);
          } else {
            store8f(out + O_CONVS + ((size_t)((row - TP) * 3 + 2) * 3072) + col, v);
          }
        } else if (col < 4096) {
#pragma unroll
          for (int q = 0; q < 8; ++q) v[q] = silu_f(v[q]);
          store8bf(Cb + (size_t)row * 2048 + 1024 + (col - 3072), v);
        } else if (col == 4096) {
#pragma unroll
          for (int q = 0; q < 8; ++q) {
            const float x = v[q] + dt_bias[q];
            const float sp = (x > 20.f) ? x : log1pf(__expf(x));
            v[q] = -__expf(a_log[q]) * sp;
          }
          store8f(Gb + (size_t)row * 8, v);
        } else if (col == 4104) {
#pragma unroll
          for (int q = 0; q < 8; ++q) v[q] = 1.f / (1.f + __expf(-v[q]));
          store8f(Betab + (size_t)row * 8, v);
        }
      }
    };
    gemm_tile(smem, 16, aload, bload, epi);
  }
}

DI void phase_poolgrp(const Params& p, char* smem, int vb, int nb, int layer) {
  char* ws = p.ws;
  const u16* Wg = (const u16*)(ws + (layer == 0 ? W_0GRP : W_3GRP));
  const float* hist = p.in[layer == 0 ? 2 : 5];
  u16* Ab = (u16*)(ws + W_A);
  const u16* Bb = (const u16*)(ws + W_B);
  const u16* Cb = (const u16*)(ws + W_C);
  for (int t = vb; t < 129 * 16; t += nb) {
    const int mt = t >> 4, g = (t >> 2) & 3, nt = t & 3;
    const int w = 2 << g;
    const u16* Bp = Wg + (size_t)g * 512 * 512 + (size_t)nt * 128 * 512;
    auto aload = [&](int rl, int k) -> uint4 {
      const int row = mt * 128 + rl, c = g * 512 + k;
      const u16* xp = Bb + (size_t)row * 2048 + c;
      float x0[8], s[8];
      unpack8(*(const uint4*)xp, x0);
#pragma unroll
      for (int q = 0; q < 8; ++q) s[q] = x0[q];
      float inv;
      if (row < TP) {
        const int tt = row & 2047;
        const int lim = min(w - 1, tt);
        for (int j = 1; j <= lim; ++j) {
          float y[8];
          unpack8(*(const uint4*)(xp - (size_t)j * 2048), y);
#pragma unroll
          for (int q = 0; q < 8; ++q) s[q] += y[q];
        }
        inv = 1.f / (float)(lim + 1);
      } else {
        const float* hp = hist + ((size_t)(row - TP) * 15) * 2048 + c;
        for (int j = 1; j < w; ++j) {
          const f32x4 y0 = *(const f32x4*)(hp + (size_t)(15 - j) * 2048);
          const f32x4 y1 = *(const f32x4*)(hp + (size_t)(15 - j) * 2048 + 4);
#pragma unroll
          for (int q = 0; q < 4; ++q) { s[q] += y0[q]; s[4 + q] += y1[q]; }
        }
        inv = 1.f / (float)w;
      }
#pragma unroll
      for (int q = 0; q < 8; ++q) s[q] = s[q] * inv - x0[q];
      return pack8(s);
    };
    auto bload = [&](int r, int k) -> uint4 { return *(const uint4*)(Bp + (size_t)r * 512 + k); };
    auto epi = [&](int rl, int cl, const f32x4& v0, const f32x4& v1) {
      const int row = mt * 128 + rl, col = g * 512 + nt * 128 + cl;
      float z[8], v[8];
      unpack8(*(const uint4*)(Cb + (size_t)row * 2048 + col), z);
#pragma unroll
      for (int q = 0; q < 4; ++q) { v[q] = v0[q] * z[q]; v[4 + q] = v1[q] * z[4 + q]; }
      store8bf(Ab + (size_t)row * 2048 + col, v);
    };
    gemm_tile(smem, 8, aload, bload, epi);
  }
}

template <int KIND>
DI void phase_outproj(const Params& p, char* smem, int vb, int nb, int layer) {
  char* ws = p.ws;
  const u16* Wt = (const u16*)(ws + (layer == 0 ? W_0OUT : layer == 1 ? W_1OUT : layer == 2 ? W_2OUT : W_3OUT));
  constexpr int KD = (KIND == 0) ? 2048 : 1024;
  const u16* Ab = (const u16*)(ws + W_A);
  const u16* Cb = (const u16*)(ws + W_C);
  const float* oss = (const float*)(ws + W_STAT) + (size_t)7 * T;
  const float* ogain = p.in[23];
  u16* xb16 = (u16*)(p.out + O_DNS);
  float* xres = p.out + O_Y;
  float* sumsq_next = (float*)(ws + W_STAT) + (size_t)(layer + 1) * T;
  const float* xp = p.in[0];
  const float* xs = p.in[1];
  for (int t = vb; t < 129 * 8; t += nb) {
    const int mt = t >> 3, nt = t & 7;
    const u16* Bp = Wt + (size_t)nt * 128 * KD;
    auto aload = [&](int rl, int k) -> uint4 {
      const int row = mt * 128 + rl;
      if (KIND == 0) {
        return *(const uint4*)(Ab + (size_t)row * 2048 + k);
      } else {
        const int h = k >> 7;
        float o[8], z[8];
        unpack8(*(const uint4*)(Cb + (size_t)row * 2048 + k), o);
        unpack8(*(const uint4*)(Cb + (size_t)row * 2048 + 1024 + k), z);
        const float rs = rsqrtf(oss[(size_t)row * 8 + h] * (1.f / 128.f) + EPS);
        const f32x4 g0 = *(const f32x4*)(ogain + (k & 127));
        const f32x4 g1 = *(const f32x4*)(ogain + (k & 127) + 4);
#pragma unroll
        for (int q = 0; q < 4; ++q) { o[q] = o[q] * rs * g0[q] * z[q]; o[4 + q] = o[4 + q] * rs * g1[q] * z[4 + q]; }
        return pack8(o);
      }
    };
    auto bload = [&](int r, int k) -> uint4 { return *(const uint4*)(Bp + (size_t)r * KD + k); };
    auto epi = [&](int rl, int cl, const f32x4& v0, const f32x4& v1) {
      const int row = mt * 128 + rl, col = nt * 128 + cl;
      const float* xo = (layer == 0) ? ((row < TP) ? xp + (size_t)row * 1024 + col : xs + (size_t)(row - TP) * 1024 + col)
                                     : xres + (size_t)row * 1024 + col;
      const f32x4 x0 = *(const f32x4*)xo, x1 = *(const f32x4*)(xo + 4);
      float v[8];
      float ss = 0.f;
#pragma unroll
      for (int q = 0; q < 4; ++q) { v[q] = x0[q] + v0[q]; v[4 + q] = x1[q] + v1[q]; }
#pragma unroll
      for (int q = 0; q < 8; ++q) ss += v[q] * v[q];
      store8f(xres + (size_t)row * 1024 + col, v);
      if (layer < 3) store8bf(xb16 + (size_t)row * 1024 + col, v);
      ss = sum8(ss);
      if ((__lane_id() & 7) == 0) atomicAdd(&sumsq_next[row], ss);
    };
    gemm_tile(smem, KD / 64, aload, bload, epi);
  }
}

DI void phase_spatial(const Params& p, char* smem, int vb, int nb) {
  char* ws = p.ws;
  const u16* W16 = (const u16*)(ws + W_1WS);
  u16* Ab = (u16*)(ws + W_A);
  const u16* Bb = (const u16*)(ws + W_B);
  const u16* Cb = (const u16*)(ws + W_C);
  const float* lnstat = (const float*)(ws + W_STAT) + (size_t)5 * T;
  const float* ln_g = p.in[13];
  const float* ln_b = p.in[14];
  const float* wsf = p.in[15];
  const float* b_s = p.in[16];
  for (int t = vb; t < 128 * 16; t += nb) {
    const int mt = t >> 4, g = (t >> 2) & 3, nt = t & 3;
    const u16* Ap = W16 + (size_t)g * 128 * 128;
    auto aload = [&](int r, int k) -> uint4 { return *(const uint4*)(Ap + (size_t)r * 128 + k); };
    auto bload = [&](int nl, int k) -> uint4 {
      const int c = g * 512 + nt * 128 + nl;
      const float lg = ln_g[c], lb = ln_b[c];
      float o[8];
#pragma unroll
      for (int jj = 0; jj < 8; ++jj) {
        const int row = mt * 128 + k + jj;
        const float x = bf2f(Bb[(size_t)row * 2048 + c]);
        const float2 stt = *(const float2*)(lnstat + (size_t)row * 2);
        const float mu = stt.x * (1.f / 2048.f);
        const float var = stt.y * (1.f / 2048.f) - mu * mu;
        o[jj] = (x - mu) * rsqrtf(var + EPS) * lg + lb;
      }
      return pack8(o);
    };
    auto epi = [&](int rl, int cl, const f32x4& v0, const f32x4& v1) {
      const int row = mt * 128 + rl, col = g * 512 + nt * 128 + cl;
      const float bs = b_s[g * 128 + rl];
      float u[8], z[8], v[8];
      unpack8(*(const uint4*)(Ab + (size_t)row * 2048 + col), u);
      unpack8(*(const uint4*)(Cb + (size_t)row * 2048 + col), z);
#pragma unroll
      for (int q = 0; q < 4; ++q) { v[q] = (v0[q] + bs) * u[q] * z[q]; v[4 + q] = (v1[q] + bs) * u[4 + q] * z[4 + q]; }
      store8bf(Ab + (size_t)row * 2048 + col, v);
    };
    gemm_tile(smem, 2, aload, bload, epi);
  }
  const int gtid = vb * 256 + TID(), gn = nb * 256;
  for (int i = gtid; i < 128 * 256; i += gn) {
    const int b = i >> 8, c = (i & 255) * 8, row = TP + b, g = c >> 9;
    const float2 stt = *(const float2*)(lnstat + (size_t)row * 2);
    const float mu = stt.x * (1.f / 2048.f);
    const float rstd = rsqrtf(stt.y * (1.f / 2048.f) - mu * mu + EPS);
    const float w00 = wsf[(size_t)g * 128 * 128], bs = b_s[g * 128];
    float x[8], u[8], z[8], vn[8], o[8];
    unpack8(*(const uint4*)(Bb + (size_t)row * 2048 + c), x);
    unpack8(*(const uint4*)(Ab + (size_t)row * 2048 + c), u);
    unpack8(*(const uint4*)(Cb + (size_t)row * 2048 + c), z);
#pragma unroll
    for (int q = 0; q < 8; ++q) {
      vn[q] = (x[q] - mu) * rstd * ln_g[c + q] + ln_b[c + q];
      o[q] = (w00 * vn[q] + bs) * u[q] * z[q];
    }
    store8f(p.out + O_SGUV + (size_t)b * 2048 + c, vn);
    store8bf(Ab + (size_t)row * 2048 + c, o);
  }
}

DI void phase_chunkprep(const Params& p, char* smem, int vb, int nb) {
  char* ws = p.ws;
  const int tid = TID(), lane = tid & 63, wid = tid >> 6, fr = lane & 15, fq = lane >> 4;
  u16* Bb = (u16*)(ws + W_B);
  u16* Cb = (u16*)(ws + W_C);
  const u16* halo = (const u16*)(ws + W_A + A_HALO);
  u16* KTT = (u16*)(ws + W_A + A_KTT);
  u16* QK = (u16*)(ws + W_A + A_QK);
  const float* Gb = (const float*)(ws + W_G);
  const float* Betab = (const float*)(ws + W_BETA);
  float* alast = (float*)(ws + W_ALAST);
  const float* cw = p.in[20];
  u16* q_s = (u16*)smem;
  u16* k_s = q_s + 64 * 136;
  u16* v_s = k_s + 64 * 136;
  float* M_s = (float*)(smem + 3 * 64 * 136 * 2);
  float* gam_s = M_s + 4096;
  float* beta_s = gam_s + 64;
  float* eg_s = beta_s + 64;
  for (int it = vb; it < 2048; it += nb) {
    const int cgi = it >> 3, h = it & 7;
    const int row0 = cgi * 64;
    const bool has_prev = (cgi & 31) != 0;
    __syncthreads();
#pragma unroll 1
    for (int part = 0; part < 3; ++part) {
      const int ch = part * 1024 + h * 128 + 2 * lane;
      const u16* src = (part < 2) ? (Bb + part * 1024 + h * 128 + 2 * lane) : (Cb + h * 128 + 2 * lane);
      float c0[4], c1[4];
#pragma unroll
      for (int j = 0; j < 4; ++j) { c0[j] = cw[j * 3072 + ch]; c1[j] = cw[j * 3072 + ch + 1]; }
      const int i0 = 16 * wid;
      float xa[3], xb[3];
#pragma unroll
      for (int j = 0; j < 3; ++j) {
        unsigned u = 0;
        if (i0 > 0) u = *(const unsigned*)(src + (size_t)(row0 + i0 - 3 + j) * 2048);
        else if (has_prev) u = *(const unsigned*)(halo + ((size_t)((cgi - 1) * 3 + j) * 3072) + ch);
        xa[j] = __uint_as_float(u << 16); xb[j] = __uint_as_float(u & 0xffff0000u);
      }
      u16* dst = (part == 0) ? q_s : (part == 1 ? k_s : v_s);
#pragma unroll 4
      for (int r = 0; r < 16; ++r) {
        const unsigned u = *(const unsigned*)(src + (size_t)(row0 + i0 + r) * 2048);
        const float na = __uint_as_float(u << 16), nb2 = __uint_as_float(u & 0xffff0000u);
        float ya = xa[0] * c0[0] + xa[1] * c0[1] + xa[2] * c0[2] + na * c0[3];
        float yb = xb[0] * c1[0] + xb[1] * c1[1] + xb[2] * c1[2] + nb2 * c1[3];
        xa[0] = xa[1]; xa[1] = xa[2]; xa[2] = na;
        xb[0] = xb[1]; xb[1] = xb[2]; xb[2] = nb2;
        ya = silu_f(ya); yb = silu_f(yb);
        if (part < 2) {
          const float ss = wave_sum(ya * ya + yb * yb);
          const float sc = rsqrtf(ss + EPS) * (part == 0 ? 0.08838834764831845f : 1.f);
          ya *= sc; yb *= sc;
        }
        *(unsigned*)(dst + (i0 + r) * 136 + 2 * lane) = pack2(ya, yb);
      }
    }
    if (tid < 64) {
      float v = Gb[(size_t)(row0 + tid) * 8 + h];
#pragma unroll
      for (int d = 1; d < 64; d <<= 1) { const float tt = __shfl_up(v, d, 64); if (lane >= d) v += tt; }
      gam_s[tid] = v;
      eg_s[tid] = __expf(v);
      beta_s[tid] = Betab[(size_t)(row0 + tid) * 8 + h];
    }
    __syncthreads();
    {
      f32x4 kk[4], qk[4];
#pragma unroll
      for (int n = 0; n < 4; ++n) { kk[n] = f32x4{0.f, 0.f, 0.f, 0.f}; qk[n] = f32x4{0.f, 0.f, 0.f, 0.f}; }
#pragma unroll
      for (int ks = 0; ks < 4; ++ks) {
        const bf16x8 ak = *(const bf16x8*)(k_s + (16 * wid + fr) * 136 + ks * 32 + fq * 8);
        const bf16x8 aq = *(const bf16x8*)(q_s + (16 * wid + fr) * 136 + ks * 32 + fq * 8);
#pragma unroll
        for (int n = 0; n < 4; ++n) {
          const bf16x8 b = *(const bf16x8*)(k_s + (n * 16 + fr) * 136 + ks * 32 + fq * 8);
          kk[n] = __builtin_amdgcn_mfma_f32_16x16x32_bf16(ak, b, kk[n], 0, 0, 0);
          qk[n] = __builtin_amdgcn_mfma_f32_16x16x32_bf16(aq, b, qk[n], 0, 0, 0);
        }
      }
#pragma unroll
      for (int n = 0; n < 4; ++n)
#pragma unroll
        for (int j = 0; j < 4; ++j) {
          const int i = 16 * wid + fq * 4 + j, jc = n * 16 + fr;
          const float d = (i >= jc) ? __expf(gam_s[i] - gam_s[jc]) : 0.f;
          M_s[i * 64 + jc] = (i > jc) ? beta_s[i] * kk[n][j] * d : 0.f;
          QK[(size_t)it * 4096 + i * 64 + jc] = f2bf(qk[n][j] * d);
        }
    }
    __syncthreads();
    {
      const int col = tid;
      const bool isu = col < 128;
      const u16* rsrc = isu ? (v_s + col) : (k_s + (col - 128));
      u16* gdst = isu ? (Cb + (size_t)row0 * 2048 + h * 128 + col) : (Bb + (size_t)row0 * 2048 + 1024 + h * 128 + (col - 128));
      float sol[64];
#pragma unroll
      for (int i = 0; i < 64; ++i) {
        float a = beta_s[i] * bf2f(rsrc[i * 136]);
        if (!isu) a *= eg_s[i];
#pragma unroll
        for (int j = 0; j < i; ++j) a -= M_s[i * 64 + j] * sol[j];
        sol[i] = a;
        gdst[(size_t)i * 2048] = f2bf(a);
      }
    }
    for (int idx = tid; idx < 64 * 16; idx += 256) {
      const int i = idx >> 4, d8 = (idx & 15) * 8;
      float f[8];
      unpack8(*(const uint4*)(q_s + i * 136 + d8), f);
      const float e = eg_s[i];
#pragma unroll
      for (int q = 0; q < 8; ++q) f[q] *= e;
      store8bf(Bb + (size_t)(row0 + i) * 2048 + h * 128 + d8, f);
    }
    {
      const int d = tid & 127, half = tid >> 7;
      const float gl = gam_s[63];
#pragma unroll
      for (int i8 = 0; i8 < 4; ++i8) {
        const int ib = (half * 4 + i8) * 8;
        float f[8];
#pragma unroll
        for (int q = 0; q < 8; ++q) f[q] = bf2f(k_s[(ib + q) * 136 + d]) * __expf(gl - gam_s[ib + q]);
        store8bf(KTT + (size_t)it * 8192 + d * 64 + ib, f);
      }
      if (tid == 0) alast[it] = __expf(gl);
    }
  }

  const float* S0all = p.in[4];
  const float* chist = p.in[3];
  float* oss = (float*)(ws + W_STAT) + (size_t)7 * T;
  float* wss = (float*)(ws + W_WSS);
  float* kss = (float*)(ws + W_KSS);
  float* egs = (float*)(ws + W_EGS);
  float* qf = (float*)smem;
  float* kf = qf + 128;
  float* vf = kf + 128;
  float* red = vf + 128;
  for (int it = vb; it < 1024; it += nb) {
    const int b = it >> 3, h = it & 7, row = TP + b;
    __syncthreads();
    if (wid < 3) {
      const int part = wid;
      float y[2];
#pragma unroll
      for (int cc = 0; cc < 2; ++cc) {
        const int d = 2 * lane + cc;
        const int ch = part * 1024 + h * 128 + d;
        const float xn = (part < 2) ? bf2f(Bb[(size_t)row * 2048 + part * 1024 + h * 128 + d]) : bf2f(Cb[(size_t)row * 2048 + h * 128 + d]);
        float a = xn * cw[3 * 3072 + ch];
#pragma unroll
        for (int j = 0; j < 3; ++j) a += chist[((size_t)(b * 3 + j) * 3072) + ch] * cw[j * 3072 + ch];
        y[cc] = silu_f(a);
      }
      if (part < 2) {
        const float ss = wave_sum(y[0] * y[0] + y[1] * y[1]);
        const float sc = rsqrtf(ss + EPS) * (part == 0 ? 0.08838834764831845f : 1.f);
        y[0] *= sc; y[1] *= sc;
      }
      float* dst = (part == 0) ? qf : (part == 1 ? kf : vf);
      dst[2 * lane] = y[0]; dst[2 * lane + 1] = y[1];
    }
    __syncthreads();
    const float g = Gb[(size_t)row * 8 + h], beta = Betab[(size_t)row * 8 + h];
    const float eg = __expf(g);
    const float* S0 = S0all + (size_t)it * 16384;
    {
      const int c4 = tid & 31, rg = tid >> 5;
      float ks[4] = {0.f, 0.f, 0.f, 0.f}, qs[4] = {0.f, 0.f, 0.f, 0.f};
#pragma unroll 4
      for (int r = 0; r < 16; ++r) {
        const int dk = rg * 16 + r;
        const f32x4 s = *(const f32x4*)(S0 + dk * 128 + c4 * 4);
        const float kv = kf[dk], qv = qf[dk];
#pragma unroll
        for (int e = 0; e < 4; ++e) { ks[e] += kv * s[e]; qs[e] += qv * s[e]; }
      }
#pragma unroll
      for (int e = 0; e < 4; ++e) { red[rg * 128 + c4 * 4 + e] = ks[e]; red[1024 + rg * 128 + c4 * 4 + e] = qs[e]; }
    }
    const float qkdot = wave_sum(qf[lane] * kf[lane] + qf[lane + 64] * kf[lane + 64]);
    __syncthreads();
    if (tid < 128) {
      const int dv = tid;
      float kS = 0.f, qS = 0.f;
#pragma unroll
      for (int rg = 0; rg < 8; ++rg) { kS += red[rg * 128 + dv]; qS += red[1024 + rg * 128 + dv]; }
      const float w = beta * (vf[dv] - eg * kS);
      const float o = eg * qS + qkdot * w;
      Cb[(size_t)row * 2048 + h * 128 + dv] = f2bf(o);
      wss[(size_t)it * 128 + dv] = w;
      kss[(size_t)it * 128 + dv] = kf[dv];
      const float s2 = wave_sum(o * o);
      if (lane == 0) atomicAdd(&oss[(size_t)row * 8 + h], s2);
      if (tid == 0) egs[it] = eg;
    }
  }
}

DI void phase_scan(const Params& p, char* smem, int vb, int nb) {
  char* ws = p.ws;
  const int tid = TID(), lane = tid & 63, wid = tid >> 6, fr = lane & 15, fq = lane >> 4;
  const u16* Bb = (const u16*)(ws + W_B);
  u16* Cb = (u16*)(ws + W_C);
  const u16* KTT = (const u16*)(ws + W_A + A_KTT);
  const u16* QK = (const u16*)(ws + W_A + A_QK);
  const float* alast = (const float*)(ws + W_ALAST);
  float* oss = (float*)(ws + W_STAT) + (size_t)7 * T;
  u16* ST = (u16*)smem;
  u16* WT = ST + 32 * 136;
  for (int it = vb; it < 256; it += nb) {
    const int b = it >> 5, h = (it >> 2) & 7, sl = it & 3;
    f32x4 S[2][2];
#pragma unroll
    for (int mi = 0; mi < 2; ++mi)
#pragma unroll
      for (int ni = 0; ni < 2; ++ni) S[mi][ni] = f32x4{0.f, 0.f, 0.f, 0.f};
    __syncthreads();
    for (int i = tid; i < 32 * 136 / 2; i += 256) ((unsigned*)ST)[i] = 0u;
    __syncthreads();
#pragma unroll 1
    for (int n = 0; n < 32; ++n) {
      const int cgi = b * 32 + n, item8 = cgi * 8 + h, row0 = cgi * 64;
      const float al = alast[item8];
      const u16* wkp = Bb + (size_t)(row0 + 16 * wid + fr) * 2048 + 1024 + h * 128 + fq * 8;
      const u16* qdp = Bb + (size_t)(row0 + 16 * wid + fr) * 2048 + h * 128 + fq * 8;
      bf16x8 awk[4], aqd[4], aqk[2], akt[2][2];
#pragma unroll
      for (int ks = 0; ks < 4; ++ks) { awk[ks] = *(const bf16x8*)(wkp + ks * 32); aqd[ks] = *(const bf16x8*)(qdp + ks * 32); }
#pragma unroll
      for (int ks = 0; ks < 2; ++ks) aqk[ks] = *(const bf16x8*)(QK + (size_t)item8 * 4096 + (16 * wid + fr) * 64 + ks * 32 + fq * 8);
#pragma unroll
      for (int mi = 0; mi < 2; ++mi)
#pragma unroll
        for (int ks = 0; ks < 2; ++ks)
          akt[mi][ks] = *(const bf16x8*)(KTT + (size_t)item8 * 8192 + ((2 * wid + mi) * 16 + fr) * 64 + ks * 32 + fq * 8);
      u16* up = Cb + (size_t)(row0 + 16 * wid + fq * 4) * 2048 + h * 128 + sl * 32 + fr;
      float uu[2][4];
#pragma unroll
      for (int ni = 0; ni < 2; ++ni)
#pragma unroll
        for (int j = 0; j < 4; ++j) uu[ni][j] = bf2f(up[(size_t)j * 2048 + ni * 16]);
      bf16x8 bs[2][4];
#pragma unroll
      for (int ni = 0; ni < 2; ++ni)
#pragma unroll
        for (int ks = 0; ks < 4; ++ks) bs[ni][ks] = *(const bf16x8*)(ST + (ni * 16 + fr) * 136 + ks * 32 + fq * 8);
      f32x4 aw[2] = {f32x4{0.f, 0.f, 0.f, 0.f}, f32x4{0.f, 0.f, 0.f, 0.f}};
#pragma unroll
      for (int ks = 0; ks < 4; ++ks)
#pragma unroll
        for (int ni = 0; ni < 2; ++ni) aw[ni] = __builtin_amdgcn_mfma_f32_16x16x32_bf16(awk[ks], bs[ni][ks], aw[ni], 0, 0, 0);
#pragma unroll
      for (int ni = 0; ni < 2; ++ni) {
        uint2 pk;
        pk.x = pack2(uu[ni][0] - aw[ni][0], uu[ni][1] - aw[ni][1]);
        pk.y = pack2(uu[ni][2] - aw[ni][2], uu[ni][3] - aw[ni][3]);
        *(uint2*)(WT + (ni * 16 + fr) * 72 + 16 * wid + fq * 4) = pk;
      }
      __syncthreads();
      bf16x8 bw[2][2];
#pragma unroll
      for (int ni = 0; ni < 2; ++ni)
#pragma unroll
        for (int ks = 0; ks < 2; ++ks) bw[ni][ks] = *(const bf16x8*)(WT + (ni * 16 + fr) * 72 + ks * 32 + fq * 8);
      f32x4 ao[2] = {f32x4{0.f, 0.f, 0.f, 0.f}, f32x4{0.f, 0.f, 0.f, 0.f}};
#pragma unroll
      for (int ni = 0; ni < 2; ++ni) {
#pragma unroll
        for (int ks = 0; ks < 4; ++ks) ao[ni] = __builtin_amdgcn_mfma_f32_16x16x32_bf16(aqd[ks], bs[ni][ks], ao[ni], 0, 0, 0);
#pragma unroll
        for (int ks = 0; ks < 2; ++ks) ao[ni] = __builtin_amdgcn_mfma_f32_16x16x32_bf16(aqk[ks], bw[ni][ks], ao[ni], 0, 0, 0);
      }
#pragma unroll
      for (int j = 0; j < 4; ++j) {
        float s2 = ao[0][j] * ao[0][j] + ao[1][j] * ao[1][j];
        s2 = sum16(s2);
        if (fr == 0) atomicAdd(&oss[(size_t)(row0 + 16 * wid + fq * 4 + j) * 8 + h], s2);
#pragma unroll
        for (int ni = 0; ni < 2; ++ni) up[(size_t)j * 2048 + ni * 16] = f2bf(ao[ni][j]);
      }
#pragma unroll
      for (int mi = 0; mi < 2; ++mi)
#pragma unroll
        for (int ni = 0; ni < 2; ++ni) {
          S[mi][ni] = S[mi][ni] * al;
#pragma unroll
          for (int ks = 0; ks < 2; ++ks) S[mi][ni] = __builtin_amdgcn_mfma_f32_16x16x32_bf16(akt[mi][ks], bw[ni][ks], S[mi][ni], 0, 0, 0);
          uint2 pk;
          pk.x = pack2(S[mi][ni][0], S[mi][ni][1]);
          pk.y = pack2(S[mi][ni][2], S[mi][ni][3]);
          *(uint2*)(ST + (ni * 16 + fr) * 136 + (2 * wid + mi) * 16 + fq * 4) = pk;
        }
      __syncthreads();
    }
    float* dst = p.out + O_DNP + (size_t)(b * 8 + h) * 16384;
#pragma unroll
    for (int mi = 0; mi < 2; ++mi)
#pragma unroll
      for (int ni = 0; ni < 2; ++ni)
#pragma unroll
        for (int j = 0; j < 4; ++j) dst[((2 * wid + mi) * 16 + fq * 4 + j) * 128 + sl * 32 + ni * 16 + fr] = S[mi][ni][j];
  }
}

DI void phase_final(const Params& p, int vb, int nb) {
  char* ws = p.ws;
  const int gtid = vb * 256 + TID(), gn = nb * 256;
  const float* sumsq = (const float*)(ws + W_STAT) + (size_t)4 * T;
  const float* gain = p.in[30];
  float* y = p.out + O_Y;
  for (int i = gtid; i < T * 256; i += gn) {
    const int row = i >> 8, c = (i & 255) * 4;
    const float rs = rsqrtf(sumsq[row] * (1.f / 1024.f) + EPS);
    f32x4 v = *(const f32x4*)(y + (size_t)row * 1024 + c);
    const f32x4 g = *(const f32x4*)(gain + c);
#pragma unroll
    for (int q = 0; q < 4; ++q) v[q] = v[q] * rs * g[q];
    *(f32x4*)(y + (size_t)row * 1024 + c) = v;
  }
  const float* S0 = p.in[4];
  const float* wss = (const float*)(ws + W_WSS);
  const float* kss = (const float*)(ws + W_KSS);
  const float* egs = (const float*)(ws + W_EGS);
  float* dS = p.out + O_DNS;
  for (int i = gtid; i < 1024 * 4096; i += gn) {
    const int it = i >> 12, dk = (i >> 5) & 127, dv = (i & 31) * 4;
    const float eg = egs[it], kv = kss[it * 128 + dk];
    const f32x4 s = *(const f32x4*)(S0 + (size_t)i * 4);
    const f32x4 w = *(const f32x4*)(wss + it * 128 + dv);
    f32x4 o;
#pragma unroll
    for (int q = 0; q < 4; ++q) o[q] = eg * s[q] + kv * w[q];
    *(f32x4*)(dS + (size_t)i * 4) = o;
  }
}

__global__ void __launch_bounds__(256, 2) mega(Params p, int ph_lo, int ph_hi, int coop) {
  __shared__ __attribute__((aligned(16))) char smem[LDS_BYTES];
  const int nb = gridDim.x;
  const int bid = blockIdx.x;
  const int vb = ((nb & 7) == 0) ? ((bid & 7) * (nb >> 3) + (bid >> 3)) : bid;
#pragma unroll 1
  for (int ph = ph_lo; ph < ph_hi; ++ph) {
    Params q = p;
    int vbl = vb, nbl = nb;
    asm volatile("" : "+s"(q.ws), "+s"(q.out), "+s"(vbl), "+s"(nbl));
    switch (ph) {
      case 0: if (PH_MASK & (1 << 0)) phase_prep(q, smem, vbl, nbl); break;
      case 1: if (PH_MASK & (1 << 1)) phase_inproj<0>(q, smem, vbl, nbl, 0); break;
      case 2: if (PH_MASK & (1 << 2)) phase_poolgrp(q, smem, vbl, nbl, 0); break;
      case 3: if (PH_MASK & (1 << 3)) phase_outproj<0>(q, smem, vbl, nbl, 0); break;
      case 4: if (PH_MASK & (1 << 4)) phase_inproj<1>(q, smem, vbl, nbl, 1); break;
      case 5: if (PH_MASK & (1 << 5)) phase_spatial(q, smem, vbl, nbl); break;
      case 6: if (PH_MASK & (1 << 6)) phase_outproj<0>(q, smem, vbl, nbl, 1); break;
      case 7: if (PH_MASK & (1 << 7)) phase_inproj<2>(q, smem, vbl, nbl, 2); break;
      case 8: if (PH_MASK & (1 << 8)) phase_chunkprep(q, smem, vbl, nbl); break;
      case 9: if (PH_MASK & (1 << 9)) phase_scan(q, smem, vbl, nbl); break;
      case 10: if (PH_MASK & (1 << 10)) phase_outproj<1>(q, smem, vbl, nbl, 2); break;
      case 11: if (PH_MASK & (1 << 11)) phase_inproj<0>(q, smem, vbl, nbl, 3); break;
      case 12: if (PH_MASK & (1 << 12)) phase_poolgrp(q, smem, vbl, nbl, 3); break;
      case 13: if (PH_MASK & (1 << 13)) phase_outproj<0>(q, smem, vbl, nbl, 3); break;
      case 14: if (PH_MASK & (1 << 14)) phase_final(q, vbl, nbl); break;
      default: break;
    }
    if (coop && ph + 1 < ph_hi) cg::this_grid().sync();
  }
}

extern "C" void kernel_launch(void* const* d_in, const int* in_sizes, int n_in, void* d_out, int out_size, void* d_ws,
                              size_t ws_size, hipStream_t stream) {
  static int grid_blocks = 0;
  if (!grid_blocks) {
    int dev = 0, cus = 0, per_cu = 0;
    hipGetDevice(&dev);
    hipDeviceGetAttribute(&cus, hipDeviceAttributeMultiprocessorCount, dev);
    hipOccupancyMaxActiveBlocksPerMultiprocessor(&per_cu, mega, 256, 0);
    if (per_cu < 1) per_cu = 1;
    if (per_cu > 2) per_cu = 2;
    grid_blocks = cus * per_cu;
  }
  Params p{};
  for (int i = 0; i < 31; ++i) p.in[i] = (const float*)d_in[i];
  p.out = (float*)d_out;
  p.ws = (char*)d_ws;
  if (ws_size < W_END) { fprintf(stderr, "workspace too small: %zu < %zu\n", ws_size, (size_t)W_END); }
#if MULTI_LAUNCH
  for (int ph = 0; ph < NPHASE; ++ph) {
    hipLaunchKernelGGL(mega, dim3(grid_blocks), dim3(256), 0, stream, p, ph, ph + 1, 0);
  }
#else
  int lo = 0, hi = NPHASE, coop = 1;
  void* args[] = {&p, &lo, &hi, &coop};
  hipError_t e = hipLaunchCooperativeKernel((void*)mega, dim3(grid_blocks), dim3(256), args, 0, stream);
  if (e != hipSuccess) fprintf(stderr, "cooperative launch failed: %s (grid %d)\n", hipGetErrorString(e), grid_blocks);
#endif
}
```

```cpp
#include <hip/hip_runtime.h>
#include <hip/hip_cooperative_groups.h>
#include <cstdio>
namespace cg = cooperative_groups;

#ifndef PH_MASK
#define PH_MASK 0x7fff
#endif
#ifndef DUP_MASK
#define DUP_MASK 0
#endif
#ifndef MULTI_LAUNCH
#define MULTI_LAUNCH 0
#endif

typedef unsigned short u16;
using bf16x8 = __attribute__((ext_vector_type(8))) short;
using f32x4 = __attribute__((ext_vector_type(4))) float;
#define DI __device__ __forceinline__

constexpr int T = 16512;
constexpr int TP = 16384;
constexpr float EPS = 1e-6f;
constexpr int NPHASE = 17;
constexpr int LDS_BYTES = 73728;

constexpr size_t O_Y = 0;
constexpr size_t O_POOL0P = (size_t)T * 1024;
constexpr size_t O_POOL0S = O_POOL0P + 8 * 15 * 2048;
constexpr size_t O_SGUV = O_POOL0S + 128 * 15 * 2048;
constexpr size_t O_CONVP = O_SGUV + 128 * 2048;
constexpr size_t O_CONVS = O_CONVP + 8 * 3 * 3072;
constexpr size_t O_DNP = O_CONVS + 128 * 3 * 3072;
constexpr size_t O_DNS = O_DNP + 8 * 8 * 128 * 128;
constexpr size_t O_POOL3P = O_DNS + (size_t)128 * 8 * 128 * 128;
constexpr size_t O_POOL3S = O_POOL3P + 8 * 15 * 2048;

constexpr size_t W_0IN = 0;
constexpr size_t W_0GRP = W_0IN + (size_t)4096 * 1024 * 2;
constexpr size_t W_0OUT = W_0GRP + (size_t)4 * 512 * 512 * 2;
constexpr size_t W_1IN = W_0OUT + (size_t)1024 * 2048 * 2;
constexpr size_t W_1WS = W_1IN + (size_t)6144 * 1024 * 2;
constexpr size_t W_1OUT = W_1WS + (size_t)4 * 128 * 128 * 2;
constexpr size_t W_2IN = W_1OUT + (size_t)1024 * 2048 * 2;
constexpr size_t W_2OUT = W_2IN + (size_t)4224 * 1024 * 2;
constexpr size_t W_3IN = W_2OUT + (size_t)1024 * 1024 * 2;
constexpr size_t W_3GRP = W_3IN + (size_t)4096 * 1024 * 2;
constexpr size_t W_3OUT = W_3GRP + (size_t)4 * 512 * 512 * 2;
constexpr size_t W_A = W_3OUT + (size_t)1024 * 2048 * 2;
constexpr size_t ABC = (size_t)T * 2048 * 2;
constexpr size_t W_B = W_A + ABC;
constexpr size_t W_C = W_B + ABC;
constexpr size_t W_STAT = W_C + ABC;
constexpr size_t W_G = W_STAT + (size_t)15 * T * 4;
constexpr size_t W_BETA = W_G + (size_t)T * 8 * 4;
constexpr size_t W_ALAST = W_BETA + (size_t)T * 8 * 4;
constexpr size_t W_WSS = W_ALAST + 2048 * 4;
constexpr size_t W_KSS = W_WSS + 128 * 8 * 128 * 4;
constexpr size_t W_EGS = W_KSS + 128 * 8 * 128 * 4;
constexpr size_t W_END = W_EGS + 128 * 8 * 4;
constexpr size_t A_HALO = 0;
constexpr size_t A_KTT = A_HALO + (size_t)256 * 3 * 3072 * 2;
constexpr size_t A_QK = A_KTT + (size_t)2048 * 8192 * 2;

struct Params {
  const float* in[31];
  float* out;
  char* ws;
};

DI int TID() { int t = threadIdx.x; asm volatile("" : "+v"(t)); return t; }
DI float bf2f(u16 x) { return __uint_as_float(((unsigned)x) << 16); }
typedef __bf16 bf16v2_t __attribute__((ext_vector_type(2)));
typedef float f32v2_t __attribute__((ext_vector_type(2)));
DI unsigned pack2(float a, float b) {
  f32v2_t f = {a, b};
  bf16v2_t h = __builtin_convertvector(f, bf16v2_t);
  return __builtin_bit_cast(unsigned, h);
}
DI u16 f2bf(float x) { return (u16)(pack2(x, 0.f) & 0xffffu); }
DI void unpack8(const uint4& u, float* f) {
  f[0] = __uint_as_float(u.x << 16); f[1] = __uint_as_float(u.x & 0xffff0000u);
  f[2] = __uint_as_float(u.y << 16); f[3] = __uint_as_float(u.y & 0xffff0000u);
  f[4] = __uint_as_float(u.z << 16); f[5] = __uint_as_float(u.z & 0xffff0000u);
  f[6] = __uint_as_float(u.w << 16); f[7] = __uint_as_float(u.w & 0xffff0000u);
}
DI uint4 pack8(const float* f) {
  uint4 u;
  u.x = pack2(f[0], f[1]); u.y = pack2(f[2], f[3]); u.z = pack2(f[4], f[5]); u.w = pack2(f[6], f[7]);
  return u;
}
DI float silu_f(float x) { return x / (1.f + __expf(-x)); }
DI float gelu_f(float x) { return 0.5f * x * (1.f + erff(x * 0.70710678118654752f)); }
DI float wave_sum(float v) {
#pragma unroll
  for (int o = 32; o > 0; o >>= 1) v += __shfl_xor(v, o, 64);
  return v;
}
DI float sum8(float v) {
  v += __shfl_xor(v, 1, 64); v += __shfl_xor(v, 2, 64); v += __shfl_xor(v, 4, 64);
  return v;
}
DI float sum16(float v) {
  v += __shfl_xor(v, 1, 64); v += __shfl_xor(v, 2, 64); v += __shfl_xor(v, 4, 64); v += __shfl_xor(v, 8, 64);
  return v;
}

template <class AL, class BL, class EP>
DI void gemm_tile(char* smem, int nk, AL aload, BL bload, EP epi) {
  const int tid = TID(), lane = tid & 63, wid = tid >> 6;
  const int wr = wid >> 1, wc = wid & 1, fr = lane & 15, fq = lane >> 4;
  f32x4 acc[4][4];
#pragma unroll
  for (int m = 0; m < 4; ++m)
#pragma unroll
    for (int n = 0; n < 4; ++n) acc[m][n] = f32x4{0.f, 0.f, 0.f, 0.f};
  const int crow = tid >> 3, ck = (tid & 7) * 8;
  uint4 ra[4], rb[4];
#pragma unroll
  for (int i = 0; i < 4; ++i) { ra[i] = aload(crow + 32 * i, ck); rb[i] = bload(crow + 32 * i, ck); }
  __syncthreads();
#pragma unroll
  for (int i = 0; i < 4; ++i) {
    *(uint4*)(smem + (crow + 32 * i) * 144 + ck * 2) = ra[i];
    *(uint4*)(smem + 18432 + (crow + 32 * i) * 144 + ck * 2) = rb[i];
  }
  __syncthreads();
  for (int kt = 0; kt < nk; ++kt) {
    const int cur = kt & 1;
    const bool more = (kt + 1 < nk);
    if (more) {
#pragma unroll
      for (int i = 0; i < 4; ++i) { ra[i] = aload(crow + 32 * i, (kt + 1) * 64 + ck); rb[i] = bload(crow + 32 * i, (kt + 1) * 64 + ck); }
    }
    const char* As = smem + cur * 36864;
    const char* Bs = As + 18432;
#pragma unroll
    for (int ks = 0; ks < 2; ++ks) {
      bf16x8 a[4], b[4];
#pragma unroll
      for (int m = 0; m < 4; ++m) a[m] = *(const bf16x8*)(As + (wr * 64 + m * 16 + fr) * 144 + ks * 64 + fq * 16);
#pragma unroll
      for (int n = 0; n < 4; ++n) b[n] = *(const bf16x8*)(Bs + (wc * 64 + n * 16 + fr) * 144 + ks * 64 + fq * 16);
#pragma unroll
      for (int m = 0; m < 4; ++m)
#pragma unroll
        for (int n = 0; n < 4; ++n) acc[m][n] = __builtin_amdgcn_mfma_f32_16x16x32_bf16(a[m], b[n], acc[m][n], 0, 0, 0);
    }
    if (more) {
      char* Ad = smem + (cur ^ 1) * 36864;
#pragma unroll
      for (int i = 0; i < 4; ++i) {
        *(uint4*)(Ad + (crow + 32 * i) * 144 + ck * 2) = ra[i];
        *(uint4*)(Ad + 18432 + (crow + 32 * i) * 144 + ck * 2) = rb[i];
      }
    }
    __syncthreads();
  }
  float* st = (float*)(smem + wid * 17408);
#pragma unroll
  for (int m = 0; m < 4; ++m)
#pragma unroll
    for (int n = 0; n < 4; ++n)
#pragma unroll
      for (int j = 0; j < 4; ++j) st[(m * 16 + fq * 4 + j) * 68 + n * 16 + fr] = acc[m][n][j];
  __syncthreads();
#pragma unroll 1
  for (int i = 0; i < 8; ++i) {
    const int r = (lane >> 3) + 8 * i, c = (lane & 7) * 8;
    f32x4 v0 = *(const f32x4*)(st + r * 68 + c);
    f32x4 v1 = *(const f32x4*)(st + r * 68 + c + 4);
    epi(wr * 64 + r, wc * 64 + c, v0, v1);
  }
}

DI void store8bf(u16* dst, const float* v) { *(uint4*)dst = pack8(v); }
DI void store8f(float* dst, const float* v) {
  *(f32x4*)dst = f32x4{v[0], v[1], v[2], v[3]};
  *(f32x4*)(dst + 4) = f32x4{v[4], v[5], v[6], v[7]};
}

DI void transpose_job(char* smem, const float* W, int K, int N, int Npad, const float* kgain, const float* nscale,
                      u16* Wt, int vb, int nb) {
  const int tid = TID();
  const int tk = K / 64, tn = Npad / 64;
  float* tile = (float*)smem;
  for (int t = vb; t < tk * tn; t += nb) {
    const int k0 = (t % tk) * 64, n0 = (t / tk) * 64;
    __syncthreads();
    {
      const int nn = tid & 63, n = n0 + nn;
      const float ns = (nscale && n < N) ? nscale[n] : 1.f;
#pragma unroll 4
      for (int i = 0; i < 16; ++i) {
        const int kk = (tid >> 6) + 4 * i;
        float v = (n < N) ? W[(size_t)(k0 + kk) * N + n] : 0.f;
        if (kgain) v *= kgain[k0 + kk];
        tile[kk * 65 + nn] = v * ns;
      }
    }
    __syncthreads();
    {
      const int nn = tid >> 2, kc = (tid & 3) * 16;
      float f[16];
#pragma unroll
      for (int q = 0; q < 16; ++q) f[q] = tile[(kc + q) * 65 + nn];
      u16* dst = Wt + (size_t)(n0 + nn) * K + k0 + kc;
      *(uint4*)dst = pack8(f);
      *(uint4*)(dst + 8) = pack8(f + 8);
    }
  }
}

DI void phase_prep(const Params& p, char* smem, int vb, int nb) {
  char* ws = p.ws;
  transpose_job(smem, p.in[7], 1024, 4096, 4096, p.in[6], nullptr, (u16*)(ws + W_0IN), vb, nb);
  for (int g = 0; g < 4; ++g)
    transpose_job(smem, p.in[8] + (size_t)g * 512 * 512, 512, 512, 512, nullptr, p.in[9] + g * 512,
                  (u16*)(ws + W_0GRP) + (size_t)g * 512 * 512, vb, nb);
  transpose_job(smem, p.in[10], 2048, 1024, 1024, nullptr, nullptr, (u16*)(ws + W_0OUT), vb, nb);
  transpose_job(smem, p.in[12], 1024, 6144, 6144, p.in[11], nullptr, (u16*)(ws + W_1IN), vb, nb);
  transpose_job(smem, p.in[17], 2048, 1024, 1024, nullptr, nullptr, (u16*)(ws + W_1OUT), vb, nb);
  transpose_job(smem, p.in[19], 1024, 4112, 4224, p.in[18], nullptr, (u16*)(ws + W_2IN), vb, nb);
  transpose_job(smem, p.in[24], 1024, 1024, 1024, nullptr, nullptr, (u16*)(ws + W_2OUT), vb, nb);
  transpose_job(smem, p.in[26], 1024, 4096, 4096, p.in[25], nullptr, (u16*)(ws + W_3IN), vb, nb);
  for (int g = 0; g < 4; ++g)
    transpose_job(smem, p.in[27] + (size_t)g * 512 * 512, 512, 512, 512, nullptr, p.in[28] + g * 512,
                  (u16*)(ws + W_3GRP) + (size_t)g * 512 * 512, vb, nb);
  transpose_job(smem, p.in[29], 2048, 1024, 1024, nullptr, nullptr, (u16*)(ws + W_3OUT), vb, nb);

  const int gtid = vb * 256 + TID(), gn = nb * 256;
  {
    u16* w16 = (u16*)(ws + W_1WS);
    const float* wsf = p.in[15];
    for (int i = gtid; i < 4 * 128 * 128; i += gn) {
      const int jj = i & 127, ii = (i >> 7) & 127;
      w16[i] = (jj <= ii) ? f2bf(wsf[i]) : (u16)0;
    }
  }
  {
    float* st = (float*)(ws + W_STAT);
    for (int i = T + gtid; i < 15 * T; i += gn) st[i] = 0.f;
  }
  {
    u16* xb16 = (u16*)(p.out + O_DNS);
    float* sumsq = (float*)(ws + W_STAT);
    const int lane = gtid & 63;
    const int gw = gtid >> 6, nw = gn >> 6;
    for (int row = gw; row < T; row += nw) {
      const float* src = (row < TP) ? p.in[0] + (size_t)row * 1024 : p.in[1] + (size_t)(row - TP) * 1024;
      float s = 0.f;
#pragma unroll
      for (int i = 0; i < 4; ++i) {
        const int c = (lane + 64 * i) * 4;
        f32x4 v = *(const f32x4*)(src + c);
        s += v[0] * v[0] + v[1] * v[1] + v[2] * v[2] + v[3] * v[3];
        uint2 o; o.x = pack2(v[0], v[1]); o.y = pack2(v[2], v[3]);
        *(uint2*)(xb16 + (size_t)row * 1024 + c) = o;
      }
      s = wave_sum(s);
      if (lane == 0) sumsq[row] = s;
    }
  }
  for (int i = gtid; i < 128 * 14 * 512; i += gn) {
    const int c4 = i & 511, r = (i >> 9) % 14, b = i / (14 * 512);
    const size_t so = ((size_t)(b * 15 + r + 1) * 2048) + c4 * 4, dof = ((size_t)(b * 15 + r) * 2048) + c4 * 4;
    *(f32x4*)(p.out + O_POOL0S + dof) = *(const f32x4*)(p.in[2] + so);
    *(f32x4*)(p.out + O_POOL3S + dof) = *(const f32x4*)(p.in[5] + so);
  }
  for (int i = gtid; i < 128 * 2 * 768; i += gn) {
    const int c4 = i % 768, r = (i / 768) & 1, b = i / (2 * 768);
    *(f32x4*)(p.out + O_CONVS + ((size_t)(b * 3 + r) * 3072) + c4 * 4) =
        *(const f32x4*)(p.in[3] + ((size_t)(b * 3 + r + 1) * 3072) + c4 * 4);
  }
}

template <int KIND>
DI void phase_inproj(const Params& p, char* smem, int vb, int nb, int layer) {
  char* ws = p.ws;
  constexpr int NT = (KIND == 0) ? 32 : (KIND == 1 ? 48 : 33);
  const u16* Wt = (const u16*)(ws + (layer == 0 ? W_0IN : layer == 1 ? W_1IN : layer == 2 ? W_2IN : W_3IN));
  const u16* xb16 = (const u16*)(p.out + O_DNS);
  const float* sumsq = (const float*)(ws + W_STAT) + (size_t)layer * T;
  u16* Ab = (u16*)(ws + W_A);
  u16* Bb = (u16*)(ws + W_B);
  u16* Cb = (u16*)(ws + W_C);
  float* lnstat = (float*)(ws + W_STAT) + (size_t)5 * T;
  float* Gb = (float*)(ws + W_G);
  float* Betab = (float*)(ws + W_BETA);
  u16* halo = (u16*)(ws + W_A + A_HALO);
  float* out = p.out;
  const float* a_log = p.in[21];
  const float* dt_bias = p.in[22];
  const size_t o_poolp = (layer == 0) ? O_POOL0P : O_POOL3P;
  const size_t o_pools = (layer == 0) ? O_POOL0S : O_POOL3S;
  for (int t = vb; t < 129 * NT; t += nb) {
    const int mt = t / NT, nt = t % NT;
    const u16* Ap = xb16 + (size_t)mt * 128 * 1024;
    const u16* Bp = Wt + (size_t)nt * 128 * 1024;
    auto aload = [&](int r, int k) -> uint4 { return *(const uint4*)(Ap + (size_t)r * 1024 + k); };
    auto bload = [&](int r, int k) -> uint4 { return *(const uint4*)(Bp + (size_t)r * 1024 + k); };
    auto epi = [&](int rl, int cl, const f32x4& v0, const f32x4& v1) {
      const int row = mt * 128 + rl, col = nt * 128 + cl;
      const float rs = rsqrtf(sumsq[row] * (1.f / 1024.f) + EPS);
      float v[8];
#pragma unroll
      for (int q = 0; q < 4; ++q) { v[q] = v0[q] * rs; v[4 + q] = v1[q] * rs; }
      if (KIND == 0) {
        if (col < 2048) {
          store8bf(Bb + (size_t)row * 2048 + col, v);
          if (row < TP) {
            const int tt = row & 2047, b = row >> 11;
            if (tt >= 2033) store8f(out + o_poolp + ((size_t)(b * 15 + tt - 2033) * 2048) + col, v);
          } else {
            store8f(out + o_pools + ((size_t)((row - TP) * 15 + 14) * 2048) + col, v);
          }
        } else {
#pragma unroll
          for (int q = 0; q < 8; ++q) v[q] = silu_f(v[q]);
          store8bf(Cb + (size_t)row * 2048 + (col - 2048), v);
        }
      } else if (KIND == 1) {
        if (col < 2048) {
#pragma unroll
          for (int q = 0; q < 8; ++q) v[q] = gelu_f(v[q]);
          store8bf(Ab + (size_t)row * 2048 + col, v);
        } else if (col < 4096) {
          float s1 = 0.f, s2 = 0.f;
#pragma unroll
          for (int q = 0; q < 8; ++q) { v[q] = gelu_f(v[q]); s1 += v[q]; s2 += v[q] * v[q]; }
          store8bf(Bb + (size_t)row * 2048 + (col - 2048), v);
          s1 = sum8(s1); s2 = sum8(s2);
          if ((__lane_id() & 7) == 0) { atomicAdd(&lnstat[row * 2], s1); atomicAdd(&lnstat[row * 2 + 1], s2); }
        } else {
#pragma unroll
          for (int q = 0; q < 8; ++q) v[q] = silu_f(v[q]);
          store8bf(Cb + (size_t)row * 2048 + (col - 4096), v);
        }
      } else {
        if (col < 3072) {
          if (col < 2048) store8bf(Bb + (size_t)row * 2048 + col, v);
          else store8bf(Cb + (size_t)row * 2048 + (col - 2048), v);
          if (row < TP) {
            const int tt = row & 2047, b = row >> 11;
            if (tt >= 2045) store8f(out + O_CONVP + ((size_t)(b * 3 + tt - 2045) * 3072) + col, v);
            if ((row & 63) >= 61) store8bf(halo + ((size_t)((row >> 6) * 3 + (row & 63) - 61) * 3072) + col, v);
          } else {
            store8f(out + O_CONVS + ((size_t)((row - TP) * 3 + 2) * 3072) + col, v);
          }
        } else if (col < 4096) {
#pragma unroll
          for (int q = 0; q < 8; ++q) v[q] = silu_f(v[q]);
          store8bf(Cb + (size_t)row * 2048 + 1024 + (col - 3072), v);
        } else if (col == 4096) {
#pragma unroll
          for (int q = 0; q < 8; ++q) {
            const float x = v[q] + dt_bias[q];
            const float sp = (x > 20.f) ? x : log1pf(__expf(x));
            v[q] = -__expf(a_log[q]) * sp;
          }
          store8f(Gb + (size_t)row * 8, v);
        } else if (col == 4104) {
#pragma unroll
          for (int q = 0; q < 8; ++q) v[q] = 1.f / (1.f + __expf(-v[q]));
          store8f(Betab + (size_t)row * 8, v);
        }
      }
    };
    gemm_tile(smem, 16, aload, bload, epi);
  }
}

DI void phase_poolpass(const Params& p, int vb, int nb, int layer) {
  char* ws = p.ws;
  const float* hist = p.in[layer == 0 ? 2 : 5];
  u16* Ab = (u16*)(ws + W_A);
  const u16* Bb = (const u16*)(ws + W_B);
  const int gtid = vb * 256 + TID(), gn = nb * 256;
  for (int i = gtid; i < 512 * 256; i += gn) {
    const int c = (i & 255) * 8, seg = i >> 8;
    const int row0 = seg * 32, t0 = row0 & 2047;
    const int w = 2 << (c >> 9);
    const u16* xp = Bb + (size_t)row0 * 2048 + c;
    float s[8];
#pragma unroll
    for (int q = 0; q < 8; ++q) s[q] = 0.f;
    const int lim = min(w, t0);
    for (int j = 1; j <= lim; ++j) {
      float y[8];
      unpack8(*(const uint4*)(xp - (size_t)j * 2048), y);
#pragma unroll
      for (int q = 0; q < 8; ++q) s[q] += y[q];
    }
#pragma unroll 4
    for (int r = 0; r < 32; ++r) {
      const int t = t0 + r;
      float x[8], o[8];
      unpack8(*(const uint4*)(xp + (size_t)r * 2048), x);
#pragma unroll
      for (int q = 0; q < 8; ++q) s[q] += x[q];
      if (t >= w) {
        float y[8];
        unpack8(*(const uint4*)(xp + (size_t)(r - w) * 2048), y);
#pragma unroll
        for (int q = 0; q < 8; ++q) s[q] -= y[q];
      }
      const float inv = 1.f / (float)min(t + 1, w);
#pragma unroll
      for (int q = 0; q < 8; ++q) o[q] = s[q] * inv - x[q];
      store8bf(Ab + (size_t)(row0 + r) * 2048 + c, o);
    }
  }
  for (int i = gtid; i < 128 * 256; i += gn) {
    const int c = (i & 255) * 8, b = i >> 8, row = TP + b;
    const int w = 2 << (c >> 9);
    float x[8], s[8];
    unpack8(*(const uint4*)(Bb + (size_t)row * 2048 + c), x);
#pragma unroll
    for (int q = 0; q < 8; ++q) s[q] = x[q];
    const float* hp = hist + ((size_t)b * 15) * 2048 + c;
    for (int j = 1; j < w; ++j) {
      const f32x4 y0 = *(const f32x4*)(hp + (size_t)(15 - j) * 2048);
      const f32x4 y1 = *(const f32x4*)(hp + (size_t)(15 - j) * 2048 + 4);
#pragma unroll
      for (int q = 0; q < 4; ++q) { s[q] += y0[q]; s[4 + q] += y1[q]; }
    }
    const float inv = 1.f / (float)w;
#pragma unroll
    for (int q = 0; q < 8; ++q) s[q] = s[q] * inv - x[q];
    store8bf(Ab + (size_t)row * 2048 + c, s);
  }
}

DI void phase_poolgrp(const Params& p, char* smem, int vb, int nb, int layer) {
  char* ws = p.ws;
  const u16* Wg = (const u16*)(ws + (layer == 0 ? W_0GRP : W_3GRP));
  const u16* Ab = (const u16*)(ws + W_A);
  u16* Bb = (u16*)(ws + W_B);
  const u16* Cb = (const u16*)(ws + W_C);
  for (int t = vb; t < 129 * 16; t += nb) {
    const int mt = t >> 4, g = (t >> 2) & 3, nt = t & 3;
    const u16* Ap = Ab + (size_t)mt * 128 * 2048 + g * 512;
    const u16* Bp = Wg + (size_t)g * 512 * 512 + (size_t)nt * 128 * 512;
    auto aload = [&](int r, int k) -> uint4 { return *(const uint4*)(Ap + (size_t)r * 2048 + k); };
    auto bload = [&](int r, int k) -> uint4 { return *(const uint4*)(Bp + (size_t)r * 512 + k); };
    auto epi = [&](int rl, int cl, const f32x4& v0, const f32x4& v1) {
      const int row = mt * 128 + rl, col = g * 512 + nt * 128 + cl;
      float z[8], v[8];
      unpack8(*(const uint4*)(Cb + (size_t)row * 2048 + col), z);
#pragma unroll
      for (int q = 0; q < 4; ++q) { v[q] = v0[q] * z[q]; v[4 + q] = v1[q] * z[4 + q]; }
      store8bf(Bb + (size_t)row * 2048 + col, v);
    };
    gemm_tile(smem, 8, aload, bload, epi);
  }
}

template <int KIND>
DI void phase_outproj(const Params& p, char* smem, int vb, int nb, int layer, bool from_b) {
  char* ws = p.ws;
  const u16* Wt = (const u16*)(ws + (layer == 0 ? W_0OUT : layer == 1 ? W_1OUT : layer == 2 ? W_2OUT : W_3OUT));
  constexpr int KD = (KIND == 0) ? 2048 : 1024;
  const u16* Ab = (const u16*)(ws + (from_b ? W_B : W_A));
  const u16* Cb = (const u16*)(ws + W_C);
  const float* oss = (const float*)(ws + W_STAT) + (size_t)7 * T;
  const float* ogain = p.in[23];
  u16* xb16 = (u16*)(p.out + O_DNS);
  float* xres = p.out + O_Y;
  float* sumsq_next = (float*)(ws + W_STAT) + (size_t)(layer + 1) * T;
  const float* xp = p.in[0];
  const float* xs = p.in[1];
  for (int t = vb; t < 129 * 8; t += nb) {
    const int mt = t >> 3, nt = t & 7;
    const u16* Bp = Wt + (size_t)nt * 128 * KD;
    auto aload = [&](int rl, int k) -> uint4 {
      const int row = mt * 128 + rl;
      if (KIND == 0) {
        return *(const uint4*)(Ab + (size_t)row * 2048 + k);
      } else {
        const int h = k >> 7;
        float o[8], z[8];
        unpack8(*(const uint4*)(Cb + (size_t)row * 2048 + k), o);
        unpack8(*(const uint4*)(Cb + (size_t)row * 2048 + 1024 + k), z);
        const float rs = rsqrtf(oss[(size_t)row * 8 + h] * (1.f / 128.f) + EPS);
        const f32x4 g0 = *(const f32x4*)(ogain + (k & 127));
        const f32x4 g1 = *(const f32x4*)(ogain + (k & 127) + 4);
#pragma unroll
        for (int q = 0; q < 4; ++q) { o[q] = o[q] * rs * g0[q] * z[q]; o[4 + q] = o[4 + q] * rs * g1[q] * z[4 + q]; }
        return pack8(o);
      }
    };
    auto bload = [&](int r, int k) -> uint4 { return *(const uint4*)(Bp + (size_t)r * KD + k); };
    auto epi = [&](int rl, int cl, const f32x4& v0, const f32x4& v1) {
      const int row = mt * 128 + rl, col = nt * 128 + cl;
      const float* xo = (layer == 0) ? ((row < TP) ? xp + (size_t)row * 1024 + col : xs + (size_t)(row - TP) * 1024 + col)
                                     : xres + (size_t)row * 1024 + col;
      const f32x4 x0 = *(const f32x4*)xo, x1 = *(const f32x4*)(xo + 4);
      float v[8];
      float ss = 0.f;
#pragma unroll
      for (int q = 0; q < 4; ++q) { v[q] = x0[q] + v0[q]; v[4 + q] = x1[q] + v1[q]; }
#pragma unroll
      for (int q = 0; q < 8; ++q) ss += v[q] * v[q];
      store8f(xres + (size_t)row * 1024 + col, v);
      if (layer < 3) store8bf(xb16 + (size_t)row * 1024 + col, v);
      ss = sum8(ss);
      if ((__lane_id() & 7) == 0) atomicAdd(&sumsq_next[row], ss);
    };
    gemm_tile(smem, KD / 64, aload, bload, epi);
  }
}

DI void phase_spatial(const Params& p, char* smem, int vb, int nb) {
  char* ws = p.ws;
  const u16* W16 = (const u16*)(ws + W_1WS);
  u16* Ab = (u16*)(ws + W_A);
  const u16* Bb = (const u16*)(ws + W_B);
  const u16* Cb = (const u16*)(ws + W_C);
  const float* lnstat = (const float*)(ws + W_STAT) + (size_t)5 * T;
  const float* ln_g = p.in[13];
  const float* ln_b = p.in[14];
  const float* wsf = p.in[15];
  const float* b_s = p.in[16];
  for (int t = vb; t < 128 * 16; t += nb) {
    const int mt = t >> 4, g = (t >> 2) & 3, nt = t & 3;
    const u16* Ap = W16 + (size_t)g * 128 * 128;
    auto aload = [&](int r, int k) -> uint4 { return *(const uint4*)(Ap + (size_t)r * 128 + k); };
    auto bload = [&](int nl, int k) -> uint4 {
      const int c = g * 512 + nt * 128 + nl;
      const float lg = ln_g[c], lb = ln_b[c];
      float o[8];
#pragma unroll
      for (int jj = 0; jj < 8; ++jj) {
        const int row = mt * 128 + k + jj;
        const float x = bf2f(Bb[(size_t)row * 2048 + c]);
        const float2 stt = *(const float2*)(lnstat + (size_t)row * 2);
        const float mu = stt.x * (1.f / 2048.f);
        const float var = stt.y * (1.f / 2048.f) - mu * mu;
        o[jj] = (x - mu) * rsqrtf(var + EPS) * lg + lb;
      }
      return pack8(o);
    };
    auto epi = [&](int rl, int cl, const f32x4& v0, const f32x4& v1) {
      const int row = mt * 128 + rl, col = g * 512 + nt * 128 + cl;
      const float bs = b_s[g * 128 + rl];
      float u[8], z[8], v[8];
      unpack8(*(const uint4*)(Ab + (size_t)row * 2048 + col), u);
      unpack8(*(const uint4*)(Cb + (size_t)row * 2048 + col), z);
#pragma unroll
      for (int q = 0; q < 4; ++q) { v[q] = (v0[q] + bs) * u[q] * z[q]; v[4 + q] = (v1[q] + bs) * u[4 + q] * z[4 + q]; }
      store8bf(Ab + (size_t)row * 2048 + col, v);
    };
    gemm_tile(smem, 2, aload, bload, epi);
  }
  const int gtid = vb * 256 + TID(), gn = nb * 256;
  for (int i = gtid; i < 128 * 256; i += gn) {
    const int b = i >> 8, c = (i & 255) * 8, row = TP + b, g = c >> 9;
    const float2 stt = *(const float2*)(lnstat + (size_t)row * 2);
    const float mu = stt.x * (1.f / 2048.f);
    const float rstd = rsqrtf(stt.y * (1.f / 2048.f) - mu * mu + EPS);
    const float w00 = wsf[(size_t)g * 128 * 128], bs = b_s[g * 128];
    float x[8], u[8], z[8], vn[8], o[8];
    unpack8(*(const uint4*)(Bb + (size_t)row * 2048 + c), x);
    unpack8(*(const uint4*)(Ab + (size_t)row * 2048 + c), u);
    unpack8(*(const uint4*)(Cb + (size_t)row * 2048 + c), z);
#pragma unroll
    for (int q = 0; q < 8; ++q) {
      vn[q] = (x[q] - mu) * rstd * ln_g[c + q] + ln_b[c + q];
      o[q] = (w00 * vn[q] + bs) * u[q] * z[q];
    }
    store8f(p.out + O_SGUV + (size_t)b * 2048 + c, vn);
    store8bf(Ab + (size_t)row * 2048 + c, o);
  }
}

DI void phase_chunkprep(const Params& p, char* smem, int vb, int nb) {
  char* ws = p.ws;
  const int tid = TID(), lane = tid & 63, wid = tid >> 6, fr = lane & 15, fq = lane >> 4;
  u16* Bb = (u16*)(ws + W_B);
  u16* Cb = (u16*)(ws + W_C);
  const u16* halo = (const u16*)(ws + W_A + A_HALO);
  u16* KTT = (u16*)(ws + W_A + A_KTT);
  u16* QK = (u16*)(ws + W_A + A_QK);
  const float* Gb = (const float*)(ws + W_G);
  const float* Betab = (const float*)(ws + W_BETA);
  float* alast = (float*)(ws + W_ALAST);
  const float* cw = p.in[20];
  u16* q_s = (u16*)smem;
  u16* k_s = q_s + 64 * 136;
  u16* v_s = k_s + 64 * 136;
  float* M_s = (float*)(smem + 3 * 64 * 136 * 2);
  float* gam_s = M_s + 4096;
  float* beta_s = gam_s + 64;
  float* eg_s = beta_s + 64;
  for (int it = vb; it < 2048; it += nb) {
    const int cgi = it >> 3, h = it & 7;
    const int row0 = cgi * 64;
    const bool has_prev = (cgi & 31) != 0;
    __syncthreads();
#pragma unroll 1
    for (int part = 0; part < 3; ++part) {
      const int ch = part * 1024 + h * 128 + 2 * lane;
      const u16* src = (part < 2) ? (Bb + part * 1024 + h * 128 + 2 * lane) : (Cb + h * 128 + 2 * lane);
      float c0[4], c1[4];
#pragma unroll
      for (int j = 0; j < 4; ++j) { c0[j] = cw[j * 3072 + ch]; c1[j] = cw[j * 3072 + ch + 1]; }
      const int i0 = 16 * wid;
      float xa[3], xb[3];
#pragma unroll
      for (int j = 0; j < 3; ++j) {
        unsigned u = 0;
        if (i0 > 0) u = *(const unsigned*)(src + (size_t)(row0 + i0 - 3 + j) * 2048);
        else if (has_prev) u = *(const unsigned*)(halo + ((size_t)((cgi - 1) * 3 + j) * 3072) + ch);
        xa[j] = __uint_as_float(u << 16); xb[j] = __uint_as_float(u & 0xffff0000u);
      }
      u16* dst = (part == 0) ? q_s : (part == 1 ? k_s : v_s);
#pragma unroll 4
      for (int r = 0; r < 16; ++r) {
        const unsigned u = *(const unsigned*)(src + (size_t)(row0 + i0 + r) * 2048);
        const float na = __uint_as_float(u << 16), nb2 = __uint_as_float(u & 0xffff0000u);
        float ya = xa[0] * c0[0] + xa[1] * c0[1] + xa[2] * c0[2] + na * c0[3];
        float yb = xb[0] * c1[0] + xb[1] * c1[1] + xb[2] * c1[2] + nb2 * c1[3];
        xa[0] = xa[1]; xa[1] = xa[2]; xa[2] = na;
        xb[0] = xb[1]; xb[1] = xb[2]; xb[2] = nb2;
        ya = silu_f(ya); yb = silu_f(yb);
        if (part < 2) {
          const float ss = wave_sum(ya * ya + yb * yb);
          const float sc = rsqrtf(ss + EPS) * (part == 0 ? 0.08838834764831845f : 1.f);
          ya *= sc; yb *= sc;
        }
        *(unsigned*)(dst + (i0 + r) * 136 + 2 * lane) = pack2(ya, yb);
      }
    }
    if (tid < 64) {
      float v = Gb[(size_t)(row0 + tid) * 8 + h];
#pragma unroll
      for (int d = 1; d < 64; d <<= 1) { const float tt = __shfl_up(v, d, 64); if (lane >= d) v += tt; }
      gam_s[tid] = v;
      eg_s[tid] = __expf(v);
      beta_s[tid] = Betab[(size_t)(row0 + tid) * 8 + h];
    }
    __syncthreads();
    {
      f32x4 kk[4], qk[4];
#pragma unroll
      for (int n = 0; n < 4; ++n) { kk[n] = f32x4{0.f, 0.f, 0.f, 0.f}; qk[n] = f32x4{0.f, 0.f, 0.f, 0.f}; }
#pragma unroll
      for (int ks = 0; ks < 4; ++ks) {
        const bf16x8 ak = *(const bf16x8*)(k_s + (16 * wid + fr) * 136 + ks * 32 + fq * 8);
        const bf16x8 aq = *(const bf16x8*)(q_s + (16 * wid + fr) * 136 + ks * 32 + fq * 8);
#pragma unroll
        for (int n = 0; n < 4; ++n) {
          const bf16x8 b = *(const bf16x8*)(k_s + (n * 16 + fr) * 136 + ks * 32 + fq * 8);
          kk[n] = __builtin_amdgcn_mfma_f32_16x16x32_bf16(ak, b, kk[n], 0, 0, 0);
          qk[n] = __builtin_amdgcn_mfma_f32_16x16x32_bf16(aq, b, qk[n], 0, 0, 0);
        }
      }
#pragma unroll
      for (int n = 0; n < 4; ++n)
#pragma unroll
        for (int j = 0; j < 4; ++j) {
          const int i = 16 * wid + fq * 4 + j, jc = n * 16 + fr;
          const float d = (i >= jc) ? __expf(gam_s[i] - gam_s[jc]) : 0.f;
          M_s[i * 64 + jc] = (i > jc) ? beta_s[i] * kk[n][j] * d : 0.f;
          QK[(size_t)it * 4096 + i * 64 + jc] = f2bf(qk[n][j] * d);
        }
    }
    __syncthreads();
    {
      const int col = tid;
      const bool isu = col < 128;
      const u16* rsrc = isu ? (v_s + col) : (k_s + (col - 128));
      u16* gdst = isu ? (Cb + (size_t)row0 * 2048 + h * 128 + col) : (Bb + (size_t)row0 * 2048 + 1024 + h * 128 + (col - 128));
      float sol[64];
#pragma unroll
      for (int i = 0; i < 64; ++i) {
        float a = beta_s[i] * bf2f(rsrc[i * 136]);
        if (!isu) a *= eg_s[i];
#pragma unroll
        for (int j = 0; j < i; ++j) a -= M_s[i * 64 + j] * sol[j];
        sol[i] = a;
        gdst[(size_t)i * 2048] = f2bf(a);
      }
    }
    for (int idx = tid; idx < 64 * 16; idx += 256) {
      const int i = idx >> 4, d8 = (idx & 15) * 8;
      float f[8];
      unpack8(*(const uint4*)(q_s + i * 136 + d8), f);
      const float e = eg_s[i];
#pragma unroll
      for (int q = 0; q < 8; ++q) f[q] *= e;
      store8bf(Bb + (size_t)(row0 + i) * 2048 + h * 128 + d8, f);
    }
    {
      const int d = tid & 127, half = tid >> 7;
      const float gl = gam_s[63];
#pragma unroll
      for (int i8 = 0; i8 < 4; ++i8) {
        const int ib = (half * 4 + i8) * 8;
        float f[8];
#pragma unroll
        for (int q = 0; q < 8; ++q) f[q] = bf2f(k_s[(ib + q) * 136 + d]) * __expf(gl - gam_s[ib + q]);
        store8bf(KTT + (size_t)it * 8192 + d * 64 + ib, f);
      }
      if (tid == 0) alast[it] = __expf(gl);
    }
  }

  const float* S0all = p.in[4];
  const float* chist = p.in[3];
  float* oss = (float*)(ws + W_STAT) + (size_t)7 * T;
  float* wss = (float*)(ws + W_WSS);
  float* kss = (float*)(ws + W_KSS);
  float* egs = (float*)(ws + W_EGS);
  float* qf = (float*)smem;
  float* kf = qf + 128;
  float* vf = kf + 128;
  float* red = vf + 128;
  for (int it = vb; it < 1024; it += nb) {
    const int b = it >> 3, h = it & 7, row = TP + b;
    __syncthreads();
    if (wid < 3) {
      const int part = wid;
      float y[2];
#pragma unroll
      for (int cc = 0; cc < 2; ++cc) {
        const int d = 2 * lane + cc;
        const int ch = part * 1024 + h * 128 + d;
        const float xn = (part < 2) ? bf2f(Bb[(size_t)row * 2048 + part * 1024 + h * 128 + d]) : bf2f(Cb[(size_t)row * 2048 + h * 128 + d]);
        float a = xn * cw[3 * 3072 + ch];
#pragma unroll
        for (int j = 0; j < 3; ++j) a += chist[((size_t)(b * 3 + j) * 3072) + ch] * cw[j * 3072 + ch];
        y[cc] = silu_f(a);
      }
      if (part < 2) {
        const float ss = wave_sum(y[0] * y[0] + y[1] * y[1]);
        const float sc = rsqrtf(ss + EPS) * (part == 0 ? 0.08838834764831845f : 1.f);
        y[0] *= sc; y[1] *= sc;
      }
      float* dst = (part == 0) ? qf : (part == 1 ? kf : vf);
      dst[2 * lane] = y[0]; dst[2 * lane + 1] = y[1];
    }
    __syncthreads();
    const float g = Gb[(size_t)row * 8 + h], beta = Betab[(size_t)row * 8 + h];
    const float eg = __expf(g);
    const float* S0 = S0all + (size_t)it * 16384;
    {
      const int c4 = tid & 31, rg = tid >> 5;
      float ks[4] = {0.f, 0.f, 0.f, 0.f}, qs[4] = {0.f, 0.f, 0.f, 0.f};
#pragma unroll 4
      for (int r = 0; r < 16; ++r) {
        const int dk = rg * 16 + r;
        const f32x4 s = *(const f32x4*)(S0 + dk * 128 + c4 * 4);
        const float kv = kf[dk], qv = qf[dk];
#pragma unroll
        for (int e = 0; e < 4; ++e) { ks[e] += kv * s[e]; qs[e] += qv * s[e]; }
      }
#pragma unroll
      for (int e = 0; e < 4; ++e) { red[rg * 128 + c4 * 4 + e] = ks[e]; red[1024 + rg * 128 + c4 * 4 + e] = qs[e]; }
    }
    const float qkdot = wave_sum(qf[lane] * kf[lane] + qf[lane + 64] * kf[lane + 64]);
    __syncthreads();
    if (tid < 128) {
      const int dv = tid;
      float kS = 0.f, qS = 0.f;
#pragma unroll
      for (int rg = 0; rg < 8; ++rg) { kS += red[rg * 128 + dv]; qS += red[1024 + rg * 128 + dv]; }
      const float w = beta * (vf[dv] - eg * kS);
      const float o = eg * qS + qkdot * w;
      Cb[(size_t)row * 2048 + h * 128 + dv] = f2bf(o);
      wss[(size_t)it * 128 + dv] = w;
      kss[(size_t)it * 128 + dv] = kf[dv];
      const float s2 = wave_sum(o * o);
      if (lane == 0) atomicAdd(&oss[(size_t)row * 8 + h], s2);
      if (tid == 0) egs[it] = eg;
    }
  }
}

DI void phase_scan(const Params& p, char* smem, int vb, int nb) {
  char* ws = p.ws;
  const int tid = TID(), lane = tid & 63, wid = tid >> 6, fr = lane & 15, fq = lane >> 4;
  const u16* Bb = (const u16*)(ws + W_B);
  u16* Cb = (u16*)(ws + W_C);
  const u16* KTT = (const u16*)(ws + W_A + A_KTT);
  const u16* QK = (const u16*)(ws + W_A + A_QK);
  const float* alast = (const float*)(ws + W_ALAST);
  float* oss = (float*)(ws + W_STAT) + (size_t)7 * T;
  u16* ST = (u16*)smem;
  u16* WT = ST + 32 * 136;
  for (int it = blockIdx.x; it < 256; it += nb) {
    const int b = it >> 5, h = (it >> 2) & 7, sl = it & 3;
    f32x4 S[2][2];
#pragma unroll
    for (int mi = 0; mi < 2; ++mi)
#pragma unroll
      for (int ni = 0; ni < 2; ++ni) S[mi][ni] = f32x4{0.f, 0.f, 0.f, 0.f};
    __syncthreads();
    for (int i = tid; i < 32 * 136 / 2; i += 256) ((unsigned*)ST)[i] = 0u;
    __syncthreads();
#pragma unroll 1
    for (int n = 0; n < 32; ++n) {
      const int cgi = b * 32 + n, item8 = cgi * 8 + h, row0 = cgi * 64;
      const float al = alast[item8];
      const u16* wkp = Bb + (size_t)(row0 + 16 * wid + fr) * 2048 + 1024 + h * 128 + fq * 8;
      const u16* qdp = Bb + (size_t)(row0 + 16 * wid + fr) * 2048 + h * 128 + fq * 8;
      bf16x8 awk[4], aqd[4], aqk[2], akt[2][2];
#pragma unroll
      for (int ks = 0; ks < 4; ++ks) { awk[ks] = *(const bf16x8*)(wkp + ks * 32); aqd[ks] = *(const bf16x8*)(qdp + ks * 32); }
#pragma unroll
      for (int ks = 0; ks < 2; ++ks) aqk[ks] = *(const bf16x8*)(QK + (size_t)item8 * 4096 + (16 * wid + fr) * 64 + ks * 32 + fq * 8);
#pragma unroll
      for (int mi = 0; mi < 2; ++mi)
#pragma unroll
        for (int ks = 0; ks < 2; ++ks)
          akt[mi][ks] = *(const bf16x8*)(KTT + (size_t)item8 * 8192 + ((2 * wid + mi) * 16 + fr) * 64 + ks * 32 + fq * 8);
      u16* up = Cb + (size_t)(row0 + 16 * wid + fq * 4) * 2048 + h * 128 + sl * 32 + fr;
      float uu[2][4];
#pragma unroll
      for (int ni = 0; ni < 2; ++ni)
#pragma unroll
        for (int j = 0; j < 4; ++j) uu[ni][j] = bf2f(up[(size_t)j * 2048 + ni * 16]);
      bf16x8 bs[2][4];
#pragma unroll
      for (int ni = 0; ni < 2; ++ni)
#pragma unroll
        for (int ks = 0; ks < 4; ++ks) bs[ni][ks] = *(const bf16x8*)(ST + (ni * 16 + fr) * 136 + ks * 32 + fq * 8);
      f32x4 aw[2] = {f32x4{0.f, 0.f, 0.f, 0.f}, f32x4{0.f, 0.f, 0.f, 0.f}};
#pragma unroll
      for (int ks = 0; ks < 4; ++ks)
#pragma unroll
        for (int ni = 0; ni < 2; ++ni) aw[ni] = __builtin_amdgcn_mfma_f32_16x16x32_bf16(awk[ks], bs[ni][ks], aw[ni], 0, 0, 0);
#pragma unroll
      for (int ni = 0; ni < 2; ++ni) {
        uint2 pk;
        pk.x = pack2(uu[ni][0] - aw[ni][0], uu[ni][1] - aw[ni][1]);
        pk.y = pack2(uu[ni][2] - aw[ni][2], uu[ni][3] - aw[ni][3]);
        *(uint2*)(WT + (ni * 16 + fr) * 72 + 16 * wid + fq * 4) = pk;
      }
      __syncthreads();
      bf16x8 bw[2][2];
#pragma unroll
      for (int ni = 0; ni < 2; ++ni)
#pragma unroll
        for (int ks = 0; ks < 2; ++ks) bw[ni][ks] = *(const bf16x8*)(WT + (ni * 16 + fr) * 72 + ks * 32 + fq * 8);
      f32x4 ao[2] = {f32x4{0.f, 0.f, 0.f, 0.f}, f32x4{0.f, 0.f, 0.f, 0.f}};
#pragma unroll
      for (int ni = 0; ni < 2; ++ni) {
#pragma unroll
        for (int ks = 0; ks < 4; ++ks) ao[ni] = __builtin_amdgcn_mfma_f32_16x16x32_bf16(aqd[ks], bs[ni][ks], ao[ni], 0, 0, 0);
#pragma unroll
        for (int ks = 0; ks < 2; ++ks) ao[ni] = __builtin_amdgcn_mfma_f32_16x16x32_bf16(aqk[ks], bw[ni][ks], ao[ni], 0, 0, 0);
      }
#pragma unroll
      for (int j = 0; j < 4; ++j) {
        float s2 = ao[0][j] * ao[0][j] + ao[1][j] * ao[1][j];
        s2 = sum16(s2);
        if (fr == 0) atomicAdd(&oss[(size_t)(row0 + 16 * wid + fq * 4 + j) * 8 + h], s2);
#pragma unroll
        for (int ni = 0; ni < 2; ++ni) up[(size_t)j * 2048 + ni * 16] = f2bf(ao[ni][j]);
      }
#pragma unroll
      for (int mi = 0; mi < 2; ++mi)
#pragma unroll
        for (int ni = 0; ni < 2; ++ni) {
          S[mi][ni] = S[mi][ni] * al;
#pragma unroll
          for (int ks = 0; ks < 2; ++ks) S[mi][ni] = __builtin_amdgcn_mfma_f32_16x16x32_bf16(akt[mi][ks], bw[ni][ks], S[mi][ni], 0, 0, 0);
          uint2 pk;
          pk.x = pack2(S[mi][ni][0], S[mi][ni][1]);
          pk.y = pack2(S[mi][ni][2], S[mi][ni][3]);
          *(uint2*)(ST + (ni * 16 + fr) * 136 + (2 * wid + mi) * 16 + fq * 4) = pk;
        }
      __syncthreads();
    }
    float* dst = p.out + O_DNP + (size_t)(b * 8 + h) * 16384;
#pragma unroll
    for (int mi = 0; mi < 2; ++mi)
#pragma unroll
      for (int ni = 0; ni < 2; ++ni)
#pragma unroll
        for (int j = 0; j < 4; ++j) dst[((2 * wid + mi) * 16 + fq * 4 + j) * 128 + sl * 32 + ni * 16 + fr] = S[mi][ni][j];
  }
}

DI void phase_final(const Params& p, int vb, int nb) {
  char* ws = p.ws;
  const int gtid = vb * 256 + TID(), gn = nb * 256;
  const float* sumsq = (const float*)(ws + W_STAT) + (size_t)4 * T;
  const float* gain = p.in[30];
  float* y = p.out + O_Y;
  for (int i = gtid; i < T * 256; i += gn) {
    const int row = i >> 8, c = (i & 255) * 4;
    const float rs = rsqrtf(sumsq[row] * (1.f / 1024.f) + EPS);
    f32x4 v = *(const f32x4*)(y + (size_t)row * 1024 + c);
    const f32x4 g = *(const f32x4*)(gain + c);
#pragma unroll
    for (int q = 0; q < 4; ++q) v[q] = v[q] * rs * g[q];
    *(f32x4*)(y + (size_t)row * 1024 + c) = v;
  }
  const float* S0 = p.in[4];
  const float* wss = (const float*)(ws + W_WSS);
  const float* kss = (const float*)(ws + W_KSS);
  const float* egs = (const float*)(ws + W_EGS);
  float* dS = p.out + O_DNS;
  for (int i = gtid; i < 1024 * 4096; i += gn) {
    const int it = i >> 12, dk = (i >> 5) & 127, dv = (i & 31) * 4;
    const float eg = egs[it], kv = kss[it * 128 + dk];
    const f32x4 s = *(const f32x4*)(S0 + (size_t)i * 4);
    const f32x4 w = *(const f32x4*)(wss + it * 128 + dv);
    f32x4 o;
#pragma unroll
    for (int q = 0; q < 4; ++q) o[q] = eg * s[q] + kv * w[q];
    *(f32x4*)(dS + (size_t)i * 4) = o;
  }
}

__global__ void __launch_bounds__(256, 2) mega(Params p, int ph_lo, int ph_hi, int coop) {
  __shared__ __attribute__((aligned(16))) char smem[LDS_BYTES];
  const int nb = gridDim.x;
  const int bid = blockIdx.x;
  const int vb = ((nb & 7) == 0) ? ((bid & 7) * (nb >> 3) + (bid >> 3)) : bid;
#pragma unroll 1
  for (int ph = ph_lo; ph < ph_hi; ++ph) {
    Params q = p;
    int vbl = vb, nbl = nb;
    asm volatile("" : "+s"(q.ws), "+s"(q.out), "+s"(vbl), "+s"(nbl));
    switch (ph) {
      case 0: phase_prep(q, smem, vbl, nbl); break;
      case 1: phase_inproj<0>(q, smem, vbl, nbl, 0); break;
      case 2: phase_poolpass(q, vbl, nbl, 0); break;
      case 3: phase_poolgrp(q, smem, vbl, nbl, 0); break;
      case 4: phase_outproj<0>(q, smem, vbl, nbl, 0, true); break;
      case 5: phase_inproj<1>(q, smem, vbl, nbl, 1); break;
      case 6: phase_spatial(q, smem, vbl, nbl); break;
      case 7: phase_outproj<0>(q, smem, vbl, nbl, 1, false); break;
      case 8: phase_inproj<2>(q, smem, vbl, nbl, 2); break;
      case 9: phase_chunkprep(q, smem, vbl, nbl); break;
      case 10: phase_scan(q, smem, vbl, nbl); break;
      case 11: phase_outproj<1>(q, smem, vbl, nbl, 2, false); break;
      case 12: phase_inproj<0>(q, smem, vbl, nbl, 3); break;
      case 13: phase_poolpass(q, vbl, nbl, 3); break;
      case 14: phase_poolgrp(q, smem, vbl, nbl, 3); break;
      case 15: phase_outproj<0>(q, smem, vbl, nbl, 3, true); break;
      case 16: phase_final(q, vbl, nbl); break;
      default: break;
    }
    if (coop && ph + 1 < ph_hi) cg::this_grid().sync();
  }
}

extern "C" void kernel_launch(void* const* d_in, const int* in_sizes, int n_in, void* d_out, int out_size, void* d_ws,
                              size_t ws_size, hipStream_t stream) {
  static int grid_blocks = 0;
  if (!grid_blocks) {
    int dev = 0, cus = 0, per_cu = 0;
    hipGetDevice(&dev);
    hipDeviceGetAttribute(&cus, hipDeviceAttributeMultiprocessorCount, dev);
    hipOccupancyMaxActiveBlocksPerMultiprocessor(&per_cu, mega, 256, 0);
    if (per_cu < 1) per_cu = 1;
    if (per_cu > 2) per_cu = 2;
    grid_blocks = cus * per_cu;
  }
  Params p{};
  for (int i = 0; i < 31; ++i) p.in[i] = (const float*)d_in[i];
  p.out = (float*)d_out;
  p.ws = (char*)d_ws;
  if (ws_size < W_END) { fprintf(stderr, "workspace too small: %zu < %zu\n", ws_size, (size_t)W_END); }
#if MULTI_LAUNCH
  for (int ph = 0; ph < NPHASE; ++ph) {
    for (int rep = 0; rep < 1 + ((DUP_MASK >> ph) & 1); ++rep)
      hipLaunchKernelGGL(mega, dim3(grid_blocks), dim3(256), 0, stream, p, ph, ph + 1, 0);
  }
#else
  int lo = 0, hi = NPHASE, coop = 1;
  void* args[] = {&p, &lo, &hi, &coop};
  hipError_t e = hipLaunchCooperativeKernel((void*)mega, dim3(grid_blocks), dim3(256), args, 0, stream);
  if (e != hipSuccess) fprintf(stderr, "cooperative launch failed: %s (grid %d)\n", hipGetErrorString(e), grid_blocks);
#endif
}
```

```cpp
#include <hip/hip_runtime.h>
#include <hip/hip_cooperative_groups.h>
#include <cstdio>
namespace cg = cooperative_groups;

#ifndef PH_MASK
#define PH_MASK 0x3ffff
#endif
#ifndef DUP_MASK
#define DUP_MASK 0
#endif
#ifndef MULTI_LAUNCH
#define MULTI_LAUNCH 0
#endif

typedef unsigned short u16;
using bf16x8 = __attribute__((ext_vector_type(8))) short;
using f32x4 = __attribute__((ext_vector_type(4))) float;
#define DI __device__ __forceinline__

constexpr int T = 16512;
constexpr int TP = 16384;
constexpr float EPS = 1e-6f;
constexpr int NPHASE = 18;
constexpr int LDS_SUB = 73728;
constexpr int LDS_BYTES = 2 * LDS_SUB;

constexpr size_t O_Y = 0;
constexpr size_t O_POOL0P = (size_t)T * 1024;
constexpr size_t O_POOL0S = O_POOL0P + 8 * 15 * 2048;
constexpr size_t O_SGUV = O_POOL0S + 128 * 15 * 2048;
constexpr size_t O_CONVP = O_SGUV + 128 * 2048;
constexpr size_t O_CONVS = O_CONVP + 8 * 3 * 3072;
constexpr size_t O_DNP = O_CONVS + 128 * 3 * 3072;
constexpr size_t O_DNS = O_DNP + 8 * 8 * 128 * 128;
constexpr size_t O_POOL3P = O_DNS + (size_t)128 * 8 * 128 * 128;
constexpr size_t O_POOL3S = O_POOL3P + 8 * 15 * 2048;

constexpr size_t W_0IN = 0;
constexpr size_t W_0GRP = W_0IN + (size_t)4096 * 1024 * 2;
constexpr size_t W_0OUT = W_0GRP + (size_t)4 * 512 * 512 * 2;
constexpr size_t W_1IN = W_0OUT + (size_t)1024 * 2048 * 2;
constexpr size_t W_1WS = W_1IN + (size_t)6144 * 1024 * 2;
constexpr size_t W_1OUT = W_1WS + (size_t)4 * 128 * 128 * 2;
constexpr size_t W_2IN = W_1OUT + (size_t)1024 * 2048 * 2;
constexpr size_t W_2OUT = W_2IN + (size_t)4224 * 1024 * 2;
constexpr size_t W_3IN = W_2OUT + (size_t)1024 * 1024 * 2;
constexpr size_t W_3GRP = W_3IN + (size_t)4096 * 1024 * 2;
constexpr size_t W_3OUT = W_3GRP + (size_t)4 * 512 * 512 * 2;
constexpr size_t W_A = W_3OUT + (size_t)1024 * 2048 * 2;
constexpr size_t ABC = (size_t)T * 2048 * 2;
constexpr size_t W_B = W_A + ABC;
constexpr size_t W_C = W_B + ABC;
constexpr size_t W_STAT = W_C + ABC;
constexpr size_t W_G = W_STAT + (size_t)15 * T * 4;
constexpr size_t W_BETA = W_G + (size_t)T * 8 * 4;
constexpr size_t W_ALAST = W_BETA + (size_t)T * 8 * 4;
constexpr size_t W_WSS = W_ALAST + 2048 * 4;
constexpr size_t W_KSS = W_WSS + 128 * 8 * 128 * 4;
constexpr size_t W_EGS = W_KSS + 128 * 8 * 128 * 4;
constexpr size_t W_BAR = W_EGS + 128 * 8 * 4;
constexpr size_t W_END = W_BAR + 4096;
constexpr size_t A_HALO = 0;
constexpr size_t A_KTT = A_HALO + (size_t)256 * 3 * 3072 * 2;
constexpr size_t A_QK = A_KTT + (size_t)2048 * 8192 * 2;

struct Params {
  const float* in[31];
  float* out;
  char* ws;
};

DI int TID() { int t = threadIdx.x; asm volatile("" : "+v"(t)); return t; }
DI float bf2f(u16 x) { return __uint_as_float(((unsigned)x) << 16); }
typedef __bf16 bf16v2_t __attribute__((ext_vector_type(2)));
typedef float f32v2_t __attribute__((ext_vector_type(2)));
DI unsigned pack2(float a, float b) {
  f32v2_t f = {a, b};
  bf16v2_t h = __builtin_convertvector(f, bf16v2_t);
  return __builtin_bit_cast(unsigned, h);
}
DI u16 f2bf(float x) { return (u16)(pack2(x, 0.f) & 0xffffu); }
DI void unpack8(const uint4& u, float* f) {
  f[0] = __uint_as_float(u.x << 16); f[1] = __uint_as_float(u.x & 0xffff0000u);
  f[2] = __uint_as_float(u.y << 16); f[3] = __uint_as_float(u.y & 0xffff0000u);
  f[4] = __uint_as_float(u.z << 16); f[5] = __uint_as_float(u.z & 0xffff0000u);
  f[6] = __uint_as_float(u.w << 16); f[7] = __uint_as_float(u.w & 0xffff0000u);
}
DI uint4 pack8(const float* f) {
  uint4 u;
  u.x = pack2(f[0], f[1]); u.y = pack2(f[2], f[3]); u.z = pack2(f[4], f[5]); u.w = pack2(f[6], f[7]);
  return u;
}
DI void lds_barrier() {
  asm volatile("s_waitcnt lgkmcnt(0)" ::: "memory");
  __builtin_amdgcn_s_barrier();
  asm volatile("" ::: "memory");
}
DI float sigm_f(float x) { return __builtin_amdgcn_rcpf(1.f + __expf(-x)); }
DI float silu_f(float x) { return x * sigm_f(x); }
DI float gelu_f(float v) {
  const float av = fabsf(v);
  const float t = __builtin_amdgcn_rcpf(av * 0.2316418882f + 1.0f);
  float q = t * 0.5307027145f + (-0.7265760135f);
  q = q * t + 0.7107068705f; q = q * t + (-0.142248368f); q = q * t + 0.127414796f; q = q * t;
  const float e = __builtin_amdgcn_exp2f((v * v) * (-0.72134752044f));
  const float m = v * (q * e);
  return v < 0.f ? m : v - m;
}
DI float wave_sum(float v) {
#pragma unroll
  for (int o = 32; o > 0; o >>= 1) v += __shfl_xor(v, o, 64);
  return v;
}
DI float sum8(float v) {
  v += __shfl_xor(v, 1, 64); v += __shfl_xor(v, 2, 64); v += __shfl_xor(v, 4, 64);
  return v;
}
DI float sum16(float v) {
  v += __shfl_xor(v, 1, 64); v += __shfl_xor(v, 2, 64); v += __shfl_xor(v, 4, 64); v += __shfl_xor(v, 8, 64);
  return v;
}

template <class AL, class BL, class EP>
DI void gemm_tile(char* smem, const int tid, int nk, AL aload, BL bload, EP epi) {
  const int lane = tid & 63, wid = tid >> 6;
  const int wr = wid >> 1, wc = wid & 1, fr = lane & 15, fq = lane >> 4;
  f32x4 acc[4][4];
#pragma unroll
  for (int m = 0; m < 4; ++m)
#pragma unroll
    for (int n = 0; n < 4; ++n) acc[m][n] = f32x4{0.f, 0.f, 0.f, 0.f};
  const int crow = tid >> 3, ck = (tid & 7) * 8;
  uint4 ra[4], rb[4];
#pragma unroll
  for (int i = 0; i < 4; ++i) { ra[i] = aload(crow + 32 * i, ck); rb[i] = bload(crow + 32 * i, ck); }
  __syncthreads();
#pragma unroll
  for (int i = 0; i < 4; ++i) {
    *(uint4*)(smem + (crow + 32 * i) * 144 + ck * 2) = ra[i];
    *(uint4*)(smem + 18432 + (crow + 32 * i) * 144 + ck * 2) = rb[i];
  }
  __syncthreads();
  for (int kt = 0; kt < nk; ++kt) {
    const int cur = kt & 1;
    const bool more = (kt + 1 < nk);
    if (more) {
#pragma unroll
      for (int i = 0; i < 4; ++i) { ra[i] = aload(crow + 32 * i, (kt + 1) * 64 + ck); rb[i] = bload(crow + 32 * i, (kt + 1) * 64 + ck); }
    }
    const char* As = smem + cur * 36864;
    const char* Bs = As + 18432;
#pragma unroll
    for (int ks = 0; ks < 2; ++ks) {
      bf16x8 a[4], b[4];
#pragma unroll
      for (int m = 0; m < 4; ++m) a[m] = *(const bf16x8*)(As + (wr * 64 + m * 16 + fr) * 144 + ks * 64 + fq * 16);
#pragma unroll
      for (int n = 0; n < 4; ++n) b[n] = *(const bf16x8*)(Bs + (wc * 64 + n * 16 + fr) * 144 + ks * 64 + fq * 16);
#pragma unroll
      for (int m = 0; m < 4; ++m)
#pragma unroll
        for (int n = 0; n < 4; ++n) acc[m][n] = __builtin_amdgcn_mfma_f32_16x16x32_bf16(a[m], b[n], acc[m][n], 0, 0, 0);
    }
    if (more) {
      char* Ad = smem + (cur ^ 1) * 36864;
#pragma unroll
      for (int i = 0; i < 4; ++i) {
        *(uint4*)(Ad + (crow + 32 * i) * 144 + ck * 2) = ra[i];
        *(uint4*)(Ad + 18432 + (crow + 32 * i) * 144 + ck * 2) = rb[i];
      }
    }
    __syncthreads();
  }
  float* st = (float*)(smem + wid * 17408);
#pragma unroll
  for (int m = 0; m < 4; ++m)
#pragma unroll
    for (int n = 0; n < 4; ++n)
#pragma unroll
      for (int j = 0; j < 4; ++j) st[(m * 16 + fq * 4 + j) * 68 + n * 16 + fr] = acc[m][n][j];
  __syncthreads();
#pragma unroll
  for (int i = 0; i < 8; ++i) {
    const int r = (lane >> 3) + 8 * i, c = (lane & 7) * 8;
    f32x4 v0 = *(const f32x4*)(st + r * 68 + c);
    f32x4 v1 = *(const f32x4*)(st + r * 68 + c + 4);
    epi(wr * 64 + r, wc * 64 + c, v0, v1);
  }
}

DI void store8bf(u16* dst, const float* v) { *(uint4*)dst = pack8(v); }
DI void store8f(float* dst, const float* v) {
  *(f32x4*)dst = f32x4{v[0], v[1], v[2], v[3]};
  *(f32x4*)(dst + 4) = f32x4{v[4], v[5], v[6], v[7]};
}


namespace pg8 {
#define PG8_LAS __attribute__((address_space(3)))
typedef unsigned short bf16_t;
typedef short bf16x8 __attribute__((ext_vector_type(8)));
typedef float f32x4 __attribute__((ext_vector_type(4)));
typedef unsigned u32x4 __attribute__((ext_vector_type(4)));
constexpr int BM = 256, BK = 64, HALF = 128, HTB = HALF * BK * 2  , STAGE_BYTES = 8 * HTB, NXCD = 8, WGM = 8;

__host__ __device__ __forceinline__ int lds_byte(int r, int c) { const int st = (r >> 4) * 2 + (c >> 5), rr = r & 15, cc = c & 31, ob = rr * 64 + cc * 2; return st * 1024 + (ob ^ (((ob >> 9) & 1) << 5)); }
__host__ __device__ __forceinline__ void stage_rc(int b, int& R, int& C) { const int st = b / 1024, sb = b % 1024, swz = sb ^ (((sb >> 9) & 1) << 5); R = (st >> 1) * 16 + swz / 64; C = (st & 1) * 32 + (swz % 64) / 2; }
__host__ __device__ __forceinline__ int perm32(int rho) { const int n = rho >> 4, i = rho & 15; return 8 * (i >> 2) + 4 * n + (i & 3); }

struct Unit { int pm, pn; };
struct Gemm { const bf16_t* A; const bf16_t* Bt; int lda, ldb, K, grp_shift; size_t grp_astride; };

struct StaticOrder {
    int nM, nN, nwg, G, c;
    __host__ __device__ void init(int M, int N, int G_, int c_) { nM = M / BM; nN = N / BM; nwg = nM * nN; G = G_; c = c_; }
    __host__ __device__ bool next(int i, Unit& u) const {
        const long L = (long)i * G + c; if (L >= nwg) return false;
        int wgid = (int)L; { const int q = nwg / NXCD, r = nwg % NXCD, xcd = wgid % NXCD, off = wgid / NXCD; wgid = (xcd < r ? xcd * (q + 1) : r * (q + 1) + (xcd - r) * q) + off; }
        const int nig = WGM * nN, gid = wgid / nig, fm = gid * WGM, gsz = (nM - fm) < WGM ? (nM - fm) : WGM;
        u.pm = fm + ((wgid % nig) % gsz); u.pn = (wgid % nig) / gsz; return true;
    }
    __device__ __forceinline__ void a_ready(const Unit&) const {}
    __device__ __forceinline__ void done(const Unit&) const {}
};

template <class Epi, class Sched, bool STAMP = false>
__device__ __forceinline__ void gemm_phase(PG8_LAS unsigned char* lds, const int tid, const Gemm g, const Sched& S, const Epi& E, unsigned long long* stamps) {
    const int wid = __builtin_amdgcn_readfirstlane(tid >> 6), lane = tid & 63, wr = wid >> 2, wc = wid & 3, fr = lane & 15, fq = lane >> 4;
    const int K = g.K, nt = K / BK;
    int ts_lo = 0, ts_hi = 0, nts = 0; const unsigned long long rt_entry = STAMP ? (unsigned long long)wall_clock64() : 0ull;
#define PG8_STAMP() do { if (STAMP && wid == 0 && nts < 64) { const unsigned long long _c = (unsigned long long)clock64(); \
        ts_lo = (lane == nts) ? (int)(unsigned)_c : ts_lo; ts_hi = (lane == nts) ? (int)(unsigned)(_c >> 32) : ts_hi; ++nts; } } while (0)
    PG8_STAMP();
    unsigned voffA[2], voffB[2];
#pragma unroll
    for (int i = 0; i < 2; ++i) { int R, C; stage_rc(tid * 16 + i * 8192, R, C); const int Rb = Epi::PERM ? ((R & ~31) + perm32(R & 31)) : R;
        voffA[i] = (unsigned)(R * g.lda + C) * 2u; voffB[i] = (unsigned)(Rb * g.ldb + C) * 2u; }
    const size_t kstep = (size_t)(BK * 2);
    const size_t hstepA = (size_t)HALF * g.lda * 2, hstepB = (size_t)HALF * g.ldb * 2;
    const size_t tstepA = 2 * hstepA, tstepB = 2 * hstepB;
    const unsigned ldsw = (unsigned)wid * 1024u;
    const int aoff = lds_byte(wr * 64 + fr, fq * 8), boff = lds_byte(wc * 32 + fr, fq * 8);
#define PG8_SA(b, h) (((b) * 2 + (h)) * HTB)
#define PG8_SB(b, h) ((4 + (b) * 2 + (h)) * HTB)
#define PG8_STAGE(bufoff, gbase, voff) do { _Pragma("unroll") for (int _i = 0; _i < 2; ++_i) \
        __builtin_amdgcn_global_load_lds((const unsigned*)((const char*)(gbase) + (voff)[_i]), (PG8_LAS unsigned*)(lds + (bufoff) + ldsw + _i * 8192), 16, 0, 0); } while (0)
#define PG8_LDA(dst, b, h) do { _Pragma("unroll") for (int m = 0; m < 4; ++m) _Pragma("unroll") for (int k = 0; k < 2; ++k) dst[m][k] = *(const PG8_LAS bf16x8*)(lds + PG8_SA(b, h) + aoff + m * 2048 + k * 1024); } while (0)
#define PG8_LDB(dst, b, h) do { _Pragma("unroll") for (int n = 0; n < 2; ++n) _Pragma("unroll") for (int k = 0; k < 2; ++k) dst[n][k] = *(const PG8_LAS bf16x8*)(lds + PG8_SB(b, h) + boff + n * 2048 + k * 1024); } while (0)
#define PG8_MMA(ai, bj, At, Bt) do { __builtin_amdgcn_s_setprio(1); _Pragma("unroll") for (int m = 0; m < 4; ++m) _Pragma("unroll") for (int n = 0; n < 2; ++n) _Pragma("unroll") for (int k = 0; k < 2; ++k) \
        acc[ai][bj][m][n] = __builtin_amdgcn_mfma_f32_16x16x32_bf16(Bt[n][k], At[m][k], acc[ai][bj][m][n], 0, 0, 0); __builtin_amdgcn_s_setprio(0); } while (0)
#define PG8_WAIT_V(n) asm volatile("s_waitcnt vmcnt(" #n ")" ::: "memory")
#define PG8_WAIT_L(n) asm volatile("s_waitcnt lgkmcnt(" #n ")" ::: "memory")
#define PG8_BAR __builtin_amdgcn_s_barrier()
#define PG8_SCHED __builtin_amdgcn_sched_barrier(0)
    Unit cur, nxt; int ui = 0;
    if (!S.next(0, cur)) return;
    f32x4 acc[2][2][4][2];
#pragma unroll
    for (int a = 0; a < 2; ++a)
#pragma unroll
        for (int b = 0; b < 2; ++b)
#pragma unroll
            for (int m = 0; m < 4; ++m)
#pragma unroll
                for (int n = 0; n < 2; ++n) acc[a][b][m][n] = (f32x4){0.f, 0.f, 0.f, 0.f};
    bf16x8 At[4][2], B0[2][2], B1[2][2];
    const char* cA = (const char*)g.A + (size_t)cur.pm * tstepA + (size_t)(cur.pn >> g.grp_shift) * g.grp_astride; const char* cB = (const char*)g.Bt + (size_t)cur.pn * tstepB;
    S.a_ready(cur);
    PG8_STAGE(PG8_SB(0, 0), cB, voffB); PG8_STAGE(PG8_SA(0, 0), cA, voffA); PG8_STAGE(PG8_SB(0, 1), cB + hstepB, voffB); PG8_STAGE(PG8_SA(0, 1), cA + hstepA, voffA);
    if (wr == 1) PG8_BAR;
    PG8_WAIT_V(4); PG8_BAR;
    PG8_STAGE(PG8_SB(1, 0), cB + kstep, voffB); PG8_STAGE(PG8_SA(1, 0), cA + kstep, voffA); PG8_STAGE(PG8_SB(1, 1), cB + hstepB + kstep, voffB);
    PG8_WAIT_V(6); PG8_BAR;
    PG8_STAMP();
    for (;;) {
        const bool has_next = S.next(ui + 1, nxt);
        const char* nA = has_next ? (const char*)g.A + (size_t)nxt.pm * tstepA + (size_t)(nxt.pn >> g.grp_shift) * g.grp_astride : cA; const char* nB = has_next ? (const char*)g.Bt + (size_t)nxt.pn * tstepB : cB;
        for (int t = 0; t < nt; t += 2) {
            const bool last = (t == nt - 2);
            const char* a1 = cA + (size_t)(t + 1) * kstep;
            const char* a2 = last ? nA : cA + (size_t)(t + 2) * kstep; const char* b2 = last ? nB : cB + (size_t)(t + 2) * kstep;
            const char* a3 = a2 + kstep; const char* b3 = b2 + kstep;
            if (last && has_next) S.a_ready(nxt);
            PG8_LDB(B0, 0, 0); PG8_SCHED; PG8_LDA(At, 0, 0); PG8_STAGE(PG8_SA(1, 1), a1 + hstepA, voffA);
            PG8_WAIT_L(8); PG8_BAR; PG8_WAIT_L(0); PG8_MMA(0, 0, At, B0); PG8_BAR; PG8_SCHED;
            PG8_LDB(B1, 0, 1); PG8_STAGE(PG8_SB(0, 0), b2, voffB);
            PG8_BAR; PG8_WAIT_L(0); PG8_MMA(0, 1, At, B1); PG8_BAR;
            PG8_LDA(At, 0, 1); PG8_STAGE(PG8_SA(0, 0), a2, voffA);
            PG8_BAR; PG8_WAIT_L(0); PG8_MMA(1, 0, At, B0); PG8_BAR; PG8_SCHED;
            PG8_STAGE(PG8_SB(0, 1), b2 + hstepB, voffB);
            PG8_WAIT_V(6); PG8_BAR; PG8_MMA(1, 1, At, B1); PG8_BAR;
            PG8_LDB(B0, 1, 0); PG8_SCHED; PG8_LDA(At, 1, 0); PG8_STAGE(PG8_SA(0, 1), a2 + hstepA, voffA);
            PG8_WAIT_L(8); PG8_BAR; PG8_WAIT_L(0); PG8_MMA(0, 0, At, B0); PG8_BAR; PG8_SCHED;
            PG8_LDB(B1, 1, 1); PG8_STAGE(PG8_SB(1, 0), b3, voffB);
            PG8_BAR; PG8_WAIT_L(0); PG8_MMA(0, 1, At, B1); PG8_BAR;
            PG8_LDA(At, 1, 1); PG8_STAGE(PG8_SA(1, 0), a3, voffA);
            PG8_BAR; PG8_WAIT_L(0); PG8_MMA(1, 0, At, B0); PG8_BAR; PG8_SCHED;
            PG8_STAGE(PG8_SB(1, 1), b3 + hstepB, voffB);
            PG8_WAIT_V(6); PG8_BAR; PG8_MMA(1, 1, At, B1); PG8_BAR;
        }
        PG8_STAMP();
        if constexpr (!Epi::AFTER_DRAIN) { E(acc, cur, wr, wc, fr, fq); S.done(cur); }
        PG8_STAMP();
        if (!has_next) break;
#pragma unroll
        for (int a = 0; a < 2; ++a)
#pragma unroll
            for (int b = 0; b < 2; ++b)
#pragma unroll
                for (int m = 0; m < 4; ++m)
#pragma unroll
                    for (int n = 0; n < 2; ++n) acc[a][b][m][n] = (f32x4){0.f, 0.f, 0.f, 0.f};
        cur = nxt; cA = nA; cB = nB; ++ui;
    }
    PG8_WAIT_V(0);
    if (wr == 0) PG8_BAR;
    PG8_BAR;
    if constexpr (Epi::AFTER_DRAIN) { E.fused(acc, cur, wr, wc, fr, fq, lds, wid, lane); S.done(cur); }
    PG8_STAMP();
    if (STAMP && wid == 0) { stamps[lane] = lane < nts ? (((unsigned long long)(unsigned)ts_hi << 32) | (unsigned)ts_lo) : 0ull;
        if (lane == 62) stamps[62] = rt_entry; if (lane == 63) stamps[63] = (unsigned long long)wall_clock64(); }
#undef PG8_STAMP
#undef PG8_SA
#undef PG8_SB
#undef PG8_STAGE
#undef PG8_LDA
#undef PG8_LDB
#undef PG8_MMA
#undef PG8_WAIT_V
#undef PG8_WAIT_L
#undef PG8_BAR
#undef PG8_SCHED
}
}

template <class F> struct EpiWrap {
  static constexpr bool PERM = true, AFTER_DRAIN = false;
  F f;
  DI void operator()(const f32x4 (&acc)[2][2][4][2], const pg8::Unit& u, int wr, int wc, int fr, int fq) const {
    float rsv[2][4];
#pragma unroll
    for (int ai = 0; ai < 2; ++ai)
#pragma unroll
      for (int m = 0; m < 4; ++m) rsv[ai][m] = f.row_scale(u.pm * 256 + ai * 128 + wr * 64 + m * 16 + fr);
    const int colb = u.pn * 256 + wc * 32 + 8 * fq;
    typename F::Pre nx0 = f.pre(u.pm * 256 + wr * 64 + fr, colb), nx1 = f.pre(u.pm * 256 + wr * 64 + fr, colb + 128);
#pragma unroll
    for (int ai = 0; ai < 2; ++ai)
#pragma unroll
      for (int m = 0; m < 4; ++m) {
        const int row = u.pm * 256 + ai * 128 + wr * 64 + m * 16 + fr;
        const float rs = rsv[ai][m];
        const typename F::Pre cu0 = nx0, cu1 = nx1;
        if (ai * 4 + m < 7) {
          const int nr = u.pm * 256 + ((ai * 4 + m + 1) >> 2) * 128 + wr * 64 + ((ai * 4 + m + 1) & 3) * 16 + fr;
          nx0 = f.pre(nr, colb); nx1 = f.pre(nr, colb + 128);
        }
        float2 part = f.elem(row, colb, acc[ai][0][m][0], acc[ai][0][m][1], rs, cu0);
        const float2 q = f.elem(row, colb + 128, acc[ai][1][m][0], acc[ai][1][m][1], rs, cu1);
        part.x += q.x; part.y += q.y;
        f.row_done(row, part, u.pn * 256);
        if (F::SERIAL) asm volatile("" ::: "memory");
      }
  }
};

template <class F>
DI void big_gemm(char* smem, const int tid, const u16* A, int lda, const u16* Bt, int ldb, int K, int N, int grp_shift,
                 size_t grp_astride, const F& f, int vb, int nb) {
  pg8::Gemm g;
  g.A = A; g.Bt = Bt; g.lda = lda; g.ldb = ldb; g.K = K; g.grp_shift = grp_shift; g.grp_astride = grp_astride;
  pg8::StaticOrder S;
  S.init(TP, N, nb, vb);
  EpiWrap<F> E{f};
  __syncthreads();
  pg8::gemm_phase<EpiWrap<F>, pg8::StaticOrder, false>((PG8_LAS unsigned char*)smem, tid, g, S, E, nullptr);
  __syncthreads();
}

template <class F>
DI void side_gemm(char* smem, const int tid, const u16* A, int lda, const u16* Bt, int ldb, int K, int row_base, int nrg,
                  int col_base, int ncg, bool grouped, const F& f, int vb, int nb) {
  const int lane = tid & 63, wid = tid >> 6, fr = lane & 15, fq = lane >> 4;
  float* red = (float*)smem;
  const int kw = K >> 3;
  for (int t = vb; t < nrg * ncg; t += nb) {
    const int rg = t % nrg, cg = t / nrg;
    const int r0 = row_base + rg * 16, c0 = col_base + cg * 32;
    const u16* ap = A + (size_t)(r0 + fr) * lda + (grouped ? (c0 >> 9) * 512 : 0) + wid * kw + fq * 8;
    const int wc0 = c0 + 8 * (fr >> 2) + (fr & 3);
    const u16* bp0 = Bt + (size_t)wc0 * ldb + wid * kw + fq * 8;
    const u16* bp1 = bp0 + (size_t)4 * ldb;
    f32x4 a0 = f32x4{0.f, 0.f, 0.f, 0.f}, a1 = f32x4{0.f, 0.f, 0.f, 0.f};
#pragma unroll 4
    for (int k = 0; k < kw; k += 32) {
      const bf16x8 av = *(const bf16x8*)(ap + k);
      const bf16x8 b0 = *(const bf16x8*)(bp0 + k);
      const bf16x8 b1 = *(const bf16x8*)(bp1 + k);
      a0 = __builtin_amdgcn_mfma_f32_16x16x32_bf16(b0, av, a0, 0, 0, 0);
      a1 = __builtin_amdgcn_mfma_f32_16x16x32_bf16(b1, av, a1, 0, 0, 0);
    }
    __syncthreads();
    *(f32x4*)(red + (wid * 64 + lane) * 8) = a0;
    *(f32x4*)(red + (wid * 64 + lane) * 8 + 4) = a1;
    __syncthreads();
    if (wid == 0) {
      f32x4 s0 = f32x4{0.f, 0.f, 0.f, 0.f}, s1 = f32x4{0.f, 0.f, 0.f, 0.f};
#pragma unroll
      for (int w = 0; w < 8; ++w) {
        s0 += *(const f32x4*)(red + (w * 64 + lane) * 8);
        s1 += *(const f32x4*)(red + (w * 64 + lane) * 8 + 4);
      }
      const int row = r0 + fr, col = c0 + 8 * fq;
      const float rs = f.row_scale(row);
      const float2 part = f.elem(row, col, s0, s1, rs, f.pre(row, col));
      f.row_done(row, part, c0 & ~255);
    }
  }
  __syncthreads();
}

DI float2 red_fq(float2 v) {
  v.x += __shfl_xor(v.x, 16, 64); v.y += __shfl_xor(v.y, 16, 64);
  v.x += __shfl_xor(v.x, 32, 64); v.y += __shfl_xor(v.y, 32, 64);
  return v;
}

template <int KIND> struct InprojF {
  static constexpr bool SERIAL = true;
  const float* sumsq; u16 *Ab, *Bb, *Cb; float* lnstat; float *Gb, *Betab; u16* halo; float* out;
  const float *a_log, *dt_bias; size_t o_poolp, o_pools;
  typedef int Pre;
  DI Pre pre(int, int) const { return 0; }
  DI float row_scale(int row) const { return rsqrtf(sumsq[row] * (1.f / 1024.f) + EPS); }
  DI float2 elem(int row, int col, const f32x4& v0, const f32x4& v1, float rs, Pre) const {
    float v[8];
    float2 part = make_float2(0.f, 0.f);
#pragma unroll
    for (int q = 0; q < 4; ++q) { v[q] = v0[q] * rs; v[4 + q] = v1[q] * rs; }
    if (KIND == 0) {
      if (col < 2048) {
        store8bf(Bb + (size_t)row * 2048 + col, v);
        if (row < TP) {
          const int tt = row & 2047, b = row >> 11;
          if (tt >= 2033) store8f(out + o_poolp + ((size_t)(b * 15 + tt - 2033) * 2048) + col, v);
        } else {
          store8f(out + o_pools + ((size_t)((row - TP) * 15 + 14) * 2048) + col, v);
        }
      } else {
#pragma unroll
        for (int q = 0; q < 8; ++q) v[q] = silu_f(v[q]);
        store8bf(Cb + (size_t)row * 2048 + (col - 2048), v);
      }
    } else if (KIND == 1) {
      if (col < 2048) {
#pragma unroll
        for (int q = 0; q < 8; ++q) v[q] = gelu_f(v[q]);
        store8bf(Ab + (size_t)row * 2048 + col, v);
      } else if (col < 4096) {
#pragma unroll
        for (int q = 0; q < 8; ++q) { v[q] = gelu_f(v[q]); part.x += v[q]; part.y += v[q] * v[q]; }
        store8bf(Bb + (size_t)row * 2048 + (col - 2048), v);
      } else {
#pragma unroll
        for (int q = 0; q < 8; ++q) v[q] = silu_f(v[q]);
        store8bf(Cb + (size_t)row * 2048 + (col - 4096), v);
      }
    } else {
      if (col < 3072) {
        if (col < 2048) store8bf(Bb + (size_t)row * 2048 + col, v);
        else store8bf(Cb + (size_t)row * 2048 + (col - 2048), v);
        if (row < TP) {
          const int tt = row & 2047, b = row >> 11;
          if (tt >= 2045) store8f(out + O_CONVP + ((size_t)(b * 3 + tt - 2045) * 3072) + col, v);
          if ((row & 63) >= 61) store8bf(halo + ((size_t)((row >> 6) * 3 + (row & 63) - 61) * 3072) + col, v);
        } else {
          store8f(out + O_CONVS + ((size_t)((row - TP) * 3 + 2) * 3072) + col, v);
        }
      } else if (col < 4096) {
#pragma unroll
        for (int q = 0; q < 8; ++q) v[q] = silu_f(v[q]);
        store8bf(Cb + (size_t)row * 2048 + 1024 + (col - 3072), v);
      }
    }
    return part;
  }
  DI void row_done(int row, float2 part, int ucol) const {
    if (KIND == 1 && ucol >= 2048 && ucol < 4096) {
      part = red_fq(part);
      if ((__lane_id() >> 4) == 0) { atomicAdd(&lnstat[row * 2], part.x); atomicAdd(&lnstat[row * 2 + 1], part.y); }
    }
  }
};


struct GdnABF {
  static constexpr bool SERIAL = true;
  const float* sumsq; float *Gb, *Betab; const float *a_log, *dt_bias;
  typedef int Pre;
  DI Pre pre(int, int) const { return 0; }
  DI float row_scale(int row) const { return rsqrtf(sumsq[row] * (1.f / 1024.f) + EPS); }
  DI float2 elem(int row, int col, const f32x4& v0, const f32x4& v1, float rs, Pre) const {
    float v[8];
#pragma unroll
    for (int q = 0; q < 4; ++q) { v[q] = v0[q] * rs; v[4 + q] = v1[q] * rs; }
    if (col == 4096) {
#pragma unroll
      for (int q = 0; q < 8; ++q) {
        const float x = v[q] + dt_bias[q];
        const float sp = (x > 20.f) ? x : __logf(1.f + __expf(x));
        v[q] = -__expf(a_log[q]) * sp;
      }
      store8f(Gb + (size_t)row * 8, v);
    } else if (col == 4104) {
#pragma unroll
      for (int q = 0; q < 8; ++q) v[q] = sigm_f(v[q]);
      store8f(Betab + (size_t)row * 8, v);
    }
    return make_float2(0.f, 0.f);
  }
  DI void row_done(int, float2, int) const {}
};

template <int KIND>
DI void phase_inproj(const Params& p, char* smem, const int tid, int vb, int nb, int layer) {
  char* ws = p.ws;
  constexpr int N = (KIND == 0) ? 4096 : (KIND == 1 ? 6144 : 4096);
  const u16* Wt = (const u16*)(ws + (layer == 0 ? W_0IN : layer == 1 ? W_1IN : layer == 2 ? W_2IN : W_3IN));
  const u16* xb16 = (const u16*)(p.out + O_DNS);
  InprojF<KIND> f;
  f.sumsq = (const float*)(ws + W_STAT) + (size_t)layer * T;
  f.Ab = (u16*)(ws + W_A); f.Bb = (u16*)(ws + W_B); f.Cb = (u16*)(ws + W_C);
  f.lnstat = (float*)(ws + W_STAT) + (size_t)5 * T;
  f.Gb = (float*)(ws + W_G); f.Betab = (float*)(ws + W_BETA);
  f.halo = (u16*)(ws + W_A + A_HALO);
  f.out = p.out; f.a_log = p.in[21]; f.dt_bias = p.in[22];
  f.o_poolp = (layer == 0) ? O_POOL0P : O_POOL3P;
  f.o_pools = (layer == 0) ? O_POOL0S : O_POOL3S;
  big_gemm(smem, tid, xb16, 1024, Wt, 1024, 1024, N, 30, 0, f, vb, nb);
  side_gemm(smem, tid, xb16, 1024, Wt, 1024, 1024, TP, 8, 0, N / 32, false, f, vb, nb);
  if (KIND == 2) {
    GdnABF fab;
    fab.sumsq = f.sumsq; fab.Gb = f.Gb; fab.Betab = f.Betab; fab.a_log = f.a_log; fab.dt_bias = f.dt_bias;
    side_gemm(smem, tid, xb16, 1024, Wt, 1024, 1024, 0, T / 16, 4096, 1, false, fab, vb, nb);
  }
}

struct PoolgrpF {
  static constexpr bool SERIAL = false;
  u16* Bb; const u16* Cb;
  DI float row_scale(int) const { return 1.f; }
  typedef uint4 Pre;
  DI Pre pre(int row, int col) const { return *(const uint4*)(Cb + (size_t)row * 2048 + col); }
  DI float2 elem(int row, int col, const f32x4& v0, const f32x4& v1, float, const Pre& zz) const {
    float z[8], v[8];
    unpack8(zz, z);
#pragma unroll
    for (int q = 0; q < 4; ++q) { v[q] = v0[q] * z[q]; v[4 + q] = v1[q] * z[4 + q]; }
    store8bf(Bb + (size_t)row * 2048 + col, v);
    return make_float2(0.f, 0.f);
  }
  DI void row_done(int, float2, int) const {}
};
DI void phase_poolgrp(const Params& p, char* smem, const int tid, int vb, int nb, int layer) {
  char* ws = p.ws;
  const u16* Wg = (const u16*)(ws + (layer == 0 ? W_0GRP : W_3GRP));
  const u16* Ab = (const u16*)(ws + W_A);
  PoolgrpF f;
  f.Bb = (u16*)(ws + W_B); f.Cb = (const u16*)(ws + W_C);
  big_gemm(smem, tid, Ab, 2048, Wg, 512, 512, 2048, 1, (size_t)512 * 2, f, vb, nb);
  side_gemm(smem, tid, Ab, 2048, Wg, 512, 512, TP, 8, 0, 64, true, f, vb, nb);
}

struct OutprojF {
  static constexpr bool SERIAL = false;
  float* xres; u16* xb16; float* sumsq_next; const float *xp, *xs; int layer;
  DI float row_scale(int) const { return 1.f; }
  struct Pre { f32x4 a, b; };
  DI Pre pre(int row, int col) const {
    const float* xo = (layer == 0) ? ((row < TP) ? xp + (size_t)row * 1024 + col : xs + (size_t)(row - TP) * 1024 + col)
                                   : xres + (size_t)row * 1024 + col;
    Pre r; r.a = *(const f32x4*)xo; r.b = *(const f32x4*)(xo + 4);
    return r;
  }
  DI float2 elem(int row, int col, const f32x4& v0, const f32x4& v1, float, const Pre& pr) const {
    const f32x4 x0 = pr.a, x1 = pr.b;
    float v[8];
    float ss = 0.f;
#pragma unroll
    for (int q = 0; q < 4; ++q) { v[q] = x0[q] + v0[q]; v[4 + q] = x1[q] + v1[q]; }
#pragma unroll
    for (int q = 0; q < 8; ++q) ss += v[q] * v[q];
    store8f(xres + (size_t)row * 1024 + col, v);
    if (layer < 3) store8bf(xb16 + (size_t)row * 1024 + col, v);
    return make_float2(ss, 0.f);
  }
  DI void row_done(int row, float2 part, int) const {
    part = red_fq(part);
    if ((__lane_id() >> 4) == 0) atomicAdd(&sumsq_next[row], part.x);
  }
};
DI void phase_outproj(const Params& p, char* smem, const int tid, int vb, int nb, int layer, int src  ) {
  char* ws = p.ws;
  const u16* Wt = (const u16*)(ws + (layer == 0 ? W_0OUT : layer == 1 ? W_1OUT : layer == 2 ? W_2OUT : W_3OUT));
  const int KD = (src == 2) ? 1024 : 2048;
  const u16* Asrc = (const u16*)(ws + (src == 1 ? W_B : W_A));
  OutprojF f;
  f.xres = p.out + O_Y; f.xb16 = (u16*)(p.out + O_DNS);
  f.sumsq_next = (float*)(ws + W_STAT) + (size_t)(layer + 1) * T;
  f.xp = p.in[0]; f.xs = p.in[1]; f.layer = layer;
  big_gemm(smem, tid, Asrc, KD, Wt, KD, KD, 1024, 30, 0, f, vb, nb);
  side_gemm(smem, tid, Asrc, KD, Wt, KD, KD, TP, 8, 0, 32, false, f, vb, nb);
}

DI void phase_ogate(const Params& p, int gtid, int gn) {
  char* ws = p.ws;
  const u16* Cb = (const u16*)(ws + W_C);
  u16* Ao = (u16*)(ws + W_A);
  const float* oss = (const float*)(ws + W_STAT) + (size_t)7 * T;
  const float* ogain = p.in[23];
  for (int i = gtid; i < T * 128; i += gn) {
    const int row = i >> 7, k = (i & 127) * 8, h = k >> 7;
    float o[8], z[8];
    unpack8(*(const uint4*)(Cb + (size_t)row * 2048 + k), o);
    unpack8(*(const uint4*)(Cb + (size_t)row * 2048 + 1024 + k), z);
    const float rs = rsqrtf(oss[(size_t)row * 8 + h] * (1.f / 128.f) + EPS);
    const f32x4 g0 = *(const f32x4*)(ogain + (k & 127));
    const f32x4 g1 = *(const f32x4*)(ogain + (k & 127) + 4);
#pragma unroll
    for (int q = 0; q < 4; ++q) { o[q] = o[q] * rs * g0[q] * z[q]; o[4 + q] = o[4 + q] * rs * g1[q] * z[4 + q]; }
    store8bf(Ao + (size_t)row * 1024 + k, o);
  }
}

DI void transpose_flat(const float* W, int K, int N, int Npad, const float* kgain, const float* nscale, u16* Wt, int gtid, int gn) {
  const int items = (K >> 5) * Npad;
  for (int i = gtid; i < items; i += gn) {
    const int kc = i / Npad, n = i - kc * Npad, k0 = kc * 32;
    float f[32];
    if (n < N) {
      const float ns = nscale ? nscale[n] : 1.f;
#pragma unroll
      for (int q = 0; q < 32; ++q) f[q] = W[(size_t)(k0 + q) * N + n];
      if (kgain) {
#pragma unroll
        for (int q = 0; q < 32; ++q) f[q] *= kgain[k0 + q];
      }
#pragma unroll
      for (int q = 0; q < 32; ++q) f[q] *= ns;
    } else {
#pragma unroll
      for (int q = 0; q < 32; ++q) f[q] = 0.f;
    }
    u16* dst = Wt + (size_t)n * K + k0;
#pragma unroll
    for (int q = 0; q < 4; ++q) *(uint4*)(dst + q * 8) = pack8(f + q * 8);
  }
}

DI void phase_prep(const Params& p, char* smem_base, const int sub, const int tid0, int vb, int nb) {
  char* smem = smem_base + sub * LDS_SUB;
  char* ws = p.ws;
  const int gtid_t = vb * 256 + tid0, gn_t = nb * 256;
  transpose_flat(p.in[7], 1024, 4096, 4096, p.in[6], nullptr, (u16*)(ws + W_0IN), gtid_t, gn_t);
  for (int g = 0; g < 4; ++g)
    transpose_flat(p.in[8] + (size_t)g * 512 * 512, 512, 512, 512, nullptr, p.in[9] + g * 512,
                  (u16*)(ws + W_0GRP) + (size_t)g * 512 * 512, gtid_t, gn_t);
  transpose_flat(p.in[10], 2048, 1024, 1024, nullptr, nullptr, (u16*)(ws + W_0OUT), gtid_t, gn_t);
  transpose_flat(p.in[12], 1024, 6144, 6144, p.in[11], nullptr, (u16*)(ws + W_1IN), gtid_t, gn_t);
  transpose_flat(p.in[17], 2048, 1024, 1024, nullptr, nullptr, (u16*)(ws + W_1OUT), gtid_t, gn_t);
  transpose_flat(p.in[19], 1024, 4112, 4224, p.in[18], nullptr, (u16*)(ws + W_2IN), gtid_t, gn_t);
  transpose_flat(p.in[24], 1024, 1024, 1024, nullptr, nullptr, (u16*)(ws + W_2OUT), gtid_t, gn_t);
  transpose_flat(p.in[26], 1024, 4096, 4096, p.in[25], nullptr, (u16*)(ws + W_3IN), gtid_t, gn_t);
  for (int g = 0; g < 4; ++g)
    transpose_flat(p.in[27] + (size_t)g * 512 * 512, 512, 512, 512, nullptr, p.in[28] + g * 512,
                  (u16*)(ws + W_3GRP) + (size_t)g * 512 * 512, gtid_t, gn_t);
  transpose_flat(p.in[29], 2048, 1024, 1024, nullptr, nullptr, (u16*)(ws + W_3OUT), gtid_t, gn_t);

  const int gtid = vb * 256 + tid0, gn = nb * 256;
  {
    u16* w16 = (u16*)(ws + W_1WS);
    const float* wsf = p.in[15];
    for (int i = gtid; i < 4 * 128 * 128; i += gn) {
      const int jj = i & 127, ii = (i >> 7) & 127;
      w16[i] = (jj <= ii) ? f2bf(wsf[i]) : (u16)0;
    }
  }
  {
    float* st = (float*)(ws + W_STAT);
    for (int i = T + gtid; i < 15 * T; i += gn) st[i] = 0.f;
  }
  {
    u16* xb16 = (u16*)(p.out + O_DNS);
    float* sumsq = (float*)(ws + W_STAT);
    const int lane = gtid & 63;
    const int gw = gtid >> 6, nw = gn >> 6;
    for (int row0 = gw; row0 < T; row0 += 4 * nw) {
      f32x4 v[4][4];
#pragma unroll
      for (int u = 0; u < 4; ++u) {
        const int row = row0 + u * nw;
        if (row < T) {
          const float* src = (row < TP) ? p.in[0] + (size_t)row * 1024 : p.in[1] + (size_t)(row - TP) * 1024;
#pragma unroll
          for (int i = 0; i < 4; ++i) v[u][i] = *(const f32x4*)(src + (lane + 64 * i) * 4);
        }
      }
#pragma unroll
      for (int u = 0; u < 4; ++u) {
        const int row = row0 + u * nw;
        if (row < T) {
          float s = 0.f;
#pragma unroll
          for (int i = 0; i < 4; ++i) {
            const int c = (lane + 64 * i) * 4;
            const f32x4 w = v[u][i];
            s += w[0] * w[0] + w[1] * w[1] + w[2] * w[2] + w[3] * w[3];
            uint2 o; o.x = pack2(w[0], w[1]); o.y = pack2(w[2], w[3]);
            *(uint2*)(xb16 + (size_t)row * 1024 + c) = o;
          }
          s = wave_sum(s);
          if (lane == 0) sumsq[row] = s;
        }
      }
    }
  }
  for (int i0 = gtid; i0 < 128 * 14 * 512; i0 += 4 * gn) {
    f32x4 va[4], vb[4];
#pragma unroll
    for (int u = 0; u < 4; ++u) {
      const int i = i0 + u * gn;
      if (i < 128 * 14 * 512) {
        const int c4 = i & 511, r = (i >> 9) % 14, b = i / (14 * 512);
        const size_t so = ((size_t)(b * 15 + r + 1) * 2048) + c4 * 4;
        va[u] = *(const f32x4*)(p.in[2] + so);
        vb[u] = *(const f32x4*)(p.in[5] + so);
      }
    }
#pragma unroll
    for (int u = 0; u < 4; ++u) {
      const int i = i0 + u * gn;
      if (i < 128 * 14 * 512) {
        const int c4 = i & 511, r = (i >> 9) % 14, b = i / (14 * 512);
        const size_t dof = ((size_t)(b * 15 + r) * 2048) + c4 * 4;
        *(f32x4*)(p.out + O_POOL0S + dof) = va[u];
        *(f32x4*)(p.out + O_POOL3S + dof) = vb[u];
      }
    }
  }
#pragma unroll 2
  for (int i = gtid; i < 128 * 2 * 768; i += gn) {
    const int c4 = i % 768, r = (i / 768) & 1, b = i / (2 * 768);
    *(f32x4*)(p.out + O_CONVS + ((size_t)(b * 3 + r) * 3072) + c4 * 4) =
        *(const f32x4*)(p.in[3] + ((size_t)(b * 3 + r + 1) * 3072) + c4 * 4);
  }
}

DI void phase_poolpass(const Params& p, const int gtid, const int gn, int layer) {
  char* ws = p.ws;
  const float* hist = p.in[layer == 0 ? 2 : 5];
  u16* Ab = (u16*)(ws + W_A);
  const u16* Bb = (const u16*)(ws + W_B);
  for (int i = gtid; i < 512 * 256; i += gn) {
    const int c = (i & 255) * 8, seg = i >> 8;
    const int row0 = seg * 32, t0 = row0 & 2047;
    const int w = 2 << (c >> 9);
    const u16* xp = Bb + (size_t)row0 * 2048 + c;
    float s[8];
#pragma unroll
    for (int q = 0; q < 8; ++q) s[q] = 0.f;
    const int lim = min(w, t0);
    for (int j = 1; j <= lim; ++j) {
      float y[8];
      unpack8(*(const uint4*)(xp - (size_t)j * 2048), y);
#pragma unroll
      for (int q = 0; q < 8; ++q) s[q] += y[q];
    }
#pragma unroll 4
    for (int r = 0; r < 32; ++r) {
      const int t = t0 + r;
      float x[8], o[8];
      unpack8(*(const uint4*)(xp + (size_t)r * 2048), x);
#pragma unroll
      for (int q = 0; q < 8; ++q) s[q] += x[q];
      if (t >= w) {
        float y[8];
        unpack8(*(const uint4*)(xp + (size_t)(r - w) * 2048), y);
#pragma unroll
        for (int q = 0; q < 8; ++q) s[q] -= y[q];
      }
      const float inv = 1.f / (float)min(t + 1, w);
#pragma unroll
      for (int q = 0; q < 8; ++q) o[q] = s[q] * inv - x[q];
      store8bf(Ab + (size_t)(row0 + r) * 2048 + c, o);
    }
  }
  for (int i = gtid; i < 128 * 256; i += gn) {
    const int c = (i & 255) * 8, b = i >> 8, row = TP + b;
    const int w = 2 << (c >> 9);
    float x[8], s[8];
    unpack8(*(const uint4*)(Bb + (size_t)row * 2048 + c), x);
#pragma unroll
    for (int q = 0; q < 8; ++q) s[q] = x[q];
    const float* hp = hist + ((size_t)b * 15) * 2048 + c;
    for (int j = 1; j < w; ++j) {
      const f32x4 y0 = *(const f32x4*)(hp + (size_t)(15 - j) * 2048);
      const f32x4 y1 = *(const f32x4*)(hp + (size_t)(15 - j) * 2048 + 4);
#pragma unroll
      for (int q = 0; q < 4; ++q) { s[q] += y0[q]; s[4 + q] += y1[q]; }
    }
    const float inv = 1.f / (float)w;
#pragma unroll
    for (int q = 0; q < 8; ++q) s[q] = s[q] * inv - x[q];
    store8bf(Ab + (size_t)row * 2048 + c, s);
  }
}

DI void phase_spatial(const Params& p, char* smem_base, const int sub, const int tid0, int vb, int nb) {
  char* smem = smem_base + sub * LDS_SUB;
  char* ws = p.ws;
  const u16* W16 = (const u16*)(ws + W_1WS);
  u16* Ab = (u16*)(ws + W_A);
  const u16* Bb = (const u16*)(ws + W_B);
  const u16* Cb = (const u16*)(ws + W_C);
  const float* lnstat = (const float*)(ws + W_STAT) + (size_t)5 * T;
  const float* ln_g = p.in[13];
  const float* ln_b = p.in[14];
  const float* wsf = p.in[15];
  const float* b_s = p.in[16];
  for (int t = vb; t < 128 * 16; t += nb) {
    const int mt = t >> 4, g = (t >> 2) & 3, nt = t & 3;
    const u16* Ap = W16 + (size_t)g * 128 * 128;
    auto aload = [&](int r, int k) -> uint4 { return *(const uint4*)(Ap + (size_t)r * 128 + k); };
    auto bload = [&](int nl, int k) -> uint4 {
      const int c = g * 512 + nt * 128 + nl;
      const float lg = ln_g[c], lb = ln_b[c];
      float o[8];
#pragma unroll
      for (int jj = 0; jj < 8; ++jj) {
        const int row = mt * 128 + k + jj;
        const float x = bf2f(Bb[(size_t)row * 2048 + c]);
        const float2 stt = *(const float2*)(lnstat + (size_t)row * 2);
        const float mu = stt.x * (1.f / 2048.f);
        const float var = stt.y * (1.f / 2048.f) - mu * mu;
        o[jj] = (x - mu) * rsqrtf(var + EPS) * lg + lb;
      }
      return pack8(o);
    };
    auto epi = [&](int rl, int cl, const f32x4& v0, const f32x4& v1) {
      const int row = mt * 128 + rl, col = g * 512 + nt * 128 + cl;
      const float bs = b_s[g * 128 + rl];
      float u[8], z[8], v[8];
      unpack8(*(const uint4*)(Ab + (size_t)row * 2048 + col), u);
      unpack8(*(const uint4*)(Cb + (size_t)row * 2048 + col), z);
#pragma unroll
      for (int q = 0; q < 4; ++q) { v[q] = (v0[q] + bs) * u[q] * z[q]; v[4 + q] = (v1[q] + bs) * u[4 + q] * z[4 + q]; }
      store8bf(Ab + (size_t)row * 2048 + col, v);
    };
    gemm_tile(smem, tid0, 2, aload, bload, epi);
  }
  const int gtid = vb * 256 + tid0, gn = nb * 256;
  for (int i = gtid; i < 128 * 256; i += gn) {
    const int b = i >> 8, c = (i & 255) * 8, row = TP + b, g = c >> 9;
    const float2 stt = *(const float2*)(lnstat + (size_t)row * 2);
    const float mu = stt.x * (1.f / 2048.f);
    const float rstd = rsqrtf(stt.y * (1.f / 2048.f) - mu * mu + EPS);
    const float w00 = wsf[(size_t)g * 128 * 128], bs = b_s[g * 128];
    float x[8], u[8], z[8], vn[8], o[8];
    unpack8(*(const uint4*)(Bb + (size_t)row * 2048 + c), x);
    unpack8(*(const uint4*)(Ab + (size_t)row * 2048 + c), u);
    unpack8(*(const uint4*)(Cb + (size_t)row * 2048 + c), z);
#pragma unroll
    for (int q = 0; q < 8; ++q) {
      vn[q] = (x[q] - mu) * rstd * ln_g[c + q] + ln_b[c + q];
      o[q] = (w00 * vn[q] + bs) * u[q] * z[q];
    }
    store8f(p.out + O_SGUV + (size_t)b * 2048 + c, vn);
    store8bf(Ab + (size_t)row * 2048 + c, o);
  }
}

DI void phase_chunkprep(const Params& p, char* smem_base, const int sub, const int tid0, int vb, int nb) {
  char* smem = smem_base + sub * LDS_SUB;
  char* ws = p.ws;
  const int tid = tid0, lane = tid & 63, wid = tid >> 6, fr = lane & 15, fq = lane >> 4;
  u16* Bb = (u16*)(ws + W_B);
  u16* Cb = (u16*)(ws + W_C);
  const u16* halo = (const u16*)(ws + W_A + A_HALO);
  u16* KTT = (u16*)(ws + W_A + A_KTT);
  u16* QK = (u16*)(ws + W_A + A_QK);
  const float* Gb = (const float*)(ws + W_G);
  const float* Betab = (const float*)(ws + W_BETA);
  float* alast = (float*)(ws + W_ALAST);
  const float* cw = p.in[20];
  u16* q_s = (u16*)smem;
  u16* k_s = q_s + 64 * 136;
  u16* v_s = k_s + 64 * 136;
  typedef __attribute__((address_space(3))) float lds_f32;
  lds_f32* M_s = (lds_f32*)(smem + 3 * 64 * 136 * 2);
  asm volatile("" : "+v"(M_s));
  lds_f32* gam_s = M_s + 4096;
  lds_f32* beta_s = gam_s + 64;
  lds_f32* eg_s = beta_s + 64;
  const int subl = vb & 1;
#pragma unroll 1
  for (int seg = 0; seg < 2; ++seg) {
  if ((seg ^ subl) == 0) {
  for (int it = vb; it < 2048; it += nb) {
    const int cgi = it >> 3, h = it & 7;
    const int row0 = cgi * 64;
    const bool has_prev = (cgi & 31) != 0;
    lds_barrier();
#pragma unroll 1
    for (int part = 0; part < 3; ++part) {
      const int ch = part * 1024 + h * 128 + 2 * lane;
      const u16* src = (part < 2) ? (Bb + part * 1024 + h * 128 + 2 * lane) : (Cb + h * 128 + 2 * lane);
      float c0[4], c1[4];
#pragma unroll
      for (int j = 0; j < 4; ++j) { c0[j] = cw[j * 3072 + ch]; c1[j] = cw[j * 3072 + ch + 1]; }
      const int i0 = 16 * wid;
      float xa[3], xb[3];
#pragma unroll
      for (int j = 0; j < 3; ++j) {
        unsigned u = 0;
        if (i0 > 0) u = *(const unsigned*)(src + (size_t)(row0 + i0 - 3 + j) * 2048);
        else if (has_prev) u = *(const unsigned*)(halo + ((size_t)((cgi - 1) * 3 + j) * 3072) + ch);
        xa[j] = __uint_as_float(u << 16); xb[j] = __uint_as_float(u & 0xffff0000u);
      }
      u16* dst = (part == 0) ? q_s : (part == 1 ? k_s : v_s);
      unsigned xr[16];
#pragma unroll
      for (int r = 0; r < 16; ++r) xr[r] = *(const unsigned*)(src + (size_t)(row0 + i0 + r) * 2048);
      float ya[16], yb[16];
#pragma unroll
      for (int r = 0; r < 16; ++r) {
        const float na = __uint_as_float(xr[r] << 16), nb2 = __uint_as_float(xr[r] & 0xffff0000u);
        const float a = xa[0] * c0[0] + xa[1] * c0[1] + xa[2] * c0[2] + na * c0[3];
        const float bq = xb[0] * c1[0] + xb[1] * c1[1] + xb[2] * c1[2] + nb2 * c1[3];
        xa[0] = xa[1]; xa[1] = xa[2]; xa[2] = na;
        xb[0] = xb[1]; xb[1] = xb[2]; xb[2] = nb2;
        ya[r] = silu_f(a); yb[r] = silu_f(bq);
      }
      if (part < 2) {
        float ss[16];
#pragma unroll
        for (int r = 0; r < 16; ++r) ss[r] = ya[r] * ya[r] + yb[r] * yb[r];
#pragma unroll
        for (int o = 32; o > 0; o >>= 1)
#pragma unroll
          for (int r = 0; r < 16; ++r) ss[r] += __shfl_xor(ss[r], o, 64);
#pragma unroll
        for (int r = 0; r < 16; ++r) {
          const float sc = rsqrtf(ss[r] + EPS) * (part == 0 ? 0.08838834764831845f : 1.f);
          ya[r] *= sc; yb[r] *= sc;
        }
      }
#pragma unroll
      for (int r = 0; r < 16; ++r) *(unsigned*)(dst + (i0 + r) * 136 + 2 * lane) = pack2(ya[r], yb[r]);
    }
    if (tid < 64) {
      float v = Gb[(size_t)(row0 + tid) * 8 + h];
#pragma unroll
      for (int d = 1; d < 64; d <<= 1) { const float tt = __shfl_up(v, d, 64); if (lane >= d) v += tt; }
      gam_s[tid] = v;
      eg_s[tid] = __expf(v);
      beta_s[tid] = Betab[(size_t)(row0 + tid) * 8 + h];
    }
    lds_barrier();
    {
      f32x4 kk[4], qk[4];
#pragma unroll
      for (int n = 0; n < 4; ++n) { kk[n] = f32x4{0.f, 0.f, 0.f, 0.f}; qk[n] = f32x4{0.f, 0.f, 0.f, 0.f}; }
#pragma unroll
      for (int ks = 0; ks < 4; ++ks) {
        const bf16x8 ak = *(const bf16x8*)(k_s + (16 * wid + fr) * 136 + ks * 32 + fq * 8);
        const bf16x8 aq = *(const bf16x8*)(q_s + (16 * wid + fr) * 136 + ks * 32 + fq * 8);
#pragma unroll
        for (int n = 0; n < 4; ++n) {
          const bf16x8 b = *(const bf16x8*)(k_s + (n * 16 + fr) * 136 + ks * 32 + fq * 8);
          kk[n] = __builtin_amdgcn_mfma_f32_16x16x32_bf16(ak, b, kk[n], 0, 0, 0);
          qk[n] = __builtin_amdgcn_mfma_f32_16x16x32_bf16(aq, b, qk[n], 0, 0, 0);
        }
      }
#pragma unroll
      for (int n = 0; n < 4; ++n)
#pragma unroll
        for (int j = 0; j < 4; ++j) {
          const int i = 16 * wid + fq * 4 + j, jc = n * 16 + fr;
          const float d = (i >= jc) ? __expf(gam_s[i] - gam_s[jc]) : 0.f;
          M_s[jc * 64 + i] = (i > jc) ? beta_s[i] * kk[n][j] * d : 0.f;
          QK[(size_t)it * 4096 + i * 64 + jc] = f2bf(qk[n][j] * d);
        }
    }
    lds_barrier();
    {
      typedef __attribute__((address_space(3))) f32x4 lds_f32x4;
      const int col = tid;
      const bool isu = col < 128;
      const u16* rsrc = isu ? (v_s + col) : (k_s + (col - 128));
      u16* gdst = isu ? (Cb + (size_t)row0 * 2048 + h * 128 + col) : (Bb + (size_t)row0 * 2048 + 1024 + h * 128 + (col - 128));
      typedef float f32x2v __attribute__((ext_vector_type(2)));
      f32x2v a2[32];
#pragma unroll
      for (int i = 0; i < 64; ++i) {
        float r = beta_s[i] * bf2f(rsrc[i * 136]);
        if (!isu) r *= eg_s[i];
        a2[i >> 1][i & 1] = r;
      }
#pragma unroll
      for (int j = 0; j < 63; ++j) {
        const float sj = a2[j >> 1][j & 1];
        const f32x2v sj2 = {sj, sj};
#pragma unroll
        for (int g = j / 4; g < 16; ++g) {
          const f32x4 m = *(const lds_f32x4*)(M_s + j * 64 + g * 4);
          if (g * 4 + 1 > j) { const f32x2v m01 = {m[0], m[1]}; a2[2 * g] -= m01 * sj2; }
          if (g * 4 + 3 > j) { const f32x2v m23 = {m[2], m[3]}; a2[2 * g + 1] -= m23 * sj2; }
        }
      }
#pragma unroll
      for (int i = 0; i < 64; ++i) gdst[(size_t)i * 2048] = f2bf(a2[i >> 1][i & 1]);
    }
    int te = tid;
    asm volatile("" : "+v"(te));
    for (int idx = te; idx < 64 * 16; idx += 256) {
      const int i = idx >> 4, d8 = (idx & 15) * 8;
      float f[8];
      unpack8(*(const uint4*)(q_s + i * 136 + d8), f);
      const float e = eg_s[i];
#pragma unroll
      for (int q = 0; q < 8; ++q) f[q] *= e;
      store8bf(Bb + (size_t)(row0 + i) * 2048 + h * 128 + d8, f);
    }
    {
      int tf = tid;
      asm volatile("" : "+v"(tf));
      const int d = tf & 127, half = tf >> 7;
      const float gl = gam_s[63];
#pragma unroll
      for (int i8 = 0; i8 < 4; ++i8) {
        const int ib = (half * 4 + i8) * 8;
        float f[8];
#pragma unroll
        for (int q = 0; q < 8; ++q) f[q] = bf2f(k_s[(ib + q) * 136 + d]) * __expf(gl - gam_s[ib + q]);
        store8bf(KTT + (size_t)it * 8192 + d * 64 + ib, f);
      }
      if (tid == 0) alast[it] = __expf(gl);
    }
  }

  } else {
  const float* S0all = p.in[4];
  const float* chist = p.in[3];
  float* oss = (float*)(ws + W_STAT) + (size_t)7 * T;
  float* wss = (float*)(ws + W_WSS);
  float* kss = (float*)(ws + W_KSS);
  float* egs = (float*)(ws + W_EGS);
  float* qf = (float*)smem;
  float* kf = qf + 128;
  float* vf = kf + 128;
  float* red = vf + 128;
  for (int it = vb; it < 1024; it += nb) {
    const int b = it >> 3, h = it & 7, row = TP + b;
    lds_barrier();
    if (wid < 3) {
      const int part = wid;
      float y[2];
#pragma unroll
      for (int cc = 0; cc < 2; ++cc) {
        const int d = 2 * lane + cc;
        const int ch = part * 1024 + h * 128 + d;
        const float xn = (part < 2) ? bf2f(Bb[(size_t)row * 2048 + part * 1024 + h * 128 + d]) : bf2f(Cb[(size_t)row * 2048 + h * 128 + d]);
        float a = xn * cw[3 * 3072 + ch];
#pragma unroll
        for (int j = 0; j < 3; ++j) a += chist[((size_t)(b * 3 + j) * 3072) + ch] * cw[j * 3072 + ch];
        y[cc] = silu_f(a);
      }
      if (part < 2) {
        const float ss = wave_sum(y[0] * y[0] + y[1] * y[1]);
        const float sc = rsqrtf(ss + EPS) * (part == 0 ? 0.08838834764831845f : 1.f);
        y[0] *= sc; y[1] *= sc;
      }
      float* dst = (part == 0) ? qf : (part == 1 ? kf : vf);
      dst[2 * lane] = y[0]; dst[2 * lane + 1] = y[1];
    }
    lds_barrier();
    const float g = Gb[(size_t)row * 8 + h], beta = Betab[(size_t)row * 8 + h];
    const float eg = __expf(g);
    const float* S0 = S0all + (size_t)it * 16384;
    {
      const int c4 = tid & 31, rg = tid >> 5;
      float ks[4] = {0.f, 0.f, 0.f, 0.f}, qs[4] = {0.f, 0.f, 0.f, 0.f};
#pragma unroll
      for (int r = 0; r < 16; ++r) {
        const int dk = rg * 16 + r;
        const f32x4 s = *(const f32x4*)(S0 + dk * 128 + c4 * 4);
        const float kv = kf[dk], qv = qf[dk];
#pragma unroll
        for (int e = 0; e < 4; ++e) { ks[e] += kv * s[e]; qs[e] += qv * s[e]; }
      }
#pragma unroll
      for (int e = 0; e < 4; ++e) { red[rg * 128 + c4 * 4 + e] = ks[e]; red[1024 + rg * 128 + c4 * 4 + e] = qs[e]; }
    }
    const float qkdot = wave_sum(qf[lane] * kf[lane] + qf[lane + 64] * kf[lane + 64]);
    lds_barrier();
    if (tid < 128) {
      const int dv = tid;
      float kS = 0.f, qS = 0.f;
#pragma unroll
      for (int rg = 0; rg < 8; ++rg) { kS += red[rg * 128 + dv]; qS += red[1024 + rg * 128 + dv]; }
      const float w = beta * (vf[dv] - eg * kS);
      const float o = eg * qS + qkdot * w;
      Cb[(size_t)row * 2048 + h * 128 + dv] = f2bf(o);
      wss[(size_t)it * 128 + dv] = w;
      kss[(size_t)it * 128 + dv] = kf[dv];
      const float s2 = wave_sum(o * o);
      if (lane == 0) atomicAdd(&oss[(size_t)row * 8 + h], s2);
      if (tid == 0) egs[it] = eg;
    }
  }
  }
  }
}

DI void phase_scan(const Params& p, char* smem, const int tid, int bid, int nb) {
  char* ws = p.ws;
  const int lane = tid & 63, wid = tid >> 6, fr = lane & 15, fq = lane >> 4;
  const int mt = wid >> 1, nt = wid & 1;
  const u16* Bb = (const u16*)(ws + W_B);
  u16* Cb = (u16*)(ws + W_C);
  const u16* KTT = (const u16*)(ws + W_A + A_KTT);
  const u16* QK = (const u16*)(ws + W_A + A_QK);
  const float* alast = (const float*)(ws + W_ALAST);
  float* oss = (float*)(ws + W_STAT) + (size_t)7 * T;
  u16* ST = (u16*)smem;
  u16* WT = ST + 32 * 136;
  for (int it = bid; it < 256; it += nb) {
    const int b = it >> 5, h = (it >> 2) & 7, sl = it & 3;
    f32x4 S0v = f32x4{0.f, 0.f, 0.f, 0.f}, S1v = f32x4{0.f, 0.f, 0.f, 0.f};
    __syncthreads();
    for (int i = tid; i < 32 * 136 / 2; i += 512) ((unsigned*)ST)[i] = 0u;
    __syncthreads();
#define SCAN_DECL(P) bf16x8 P##wk0, P##wk1, P##wk2, P##wk3, P##qd0, P##qd1, P##qd2, P##qd3, P##qk0, P##qk1, P##kt0, P##kt1; f32x4 P##uu; float P##al
#define SCAN_LOAD_OPS(nn, P) do { \
      const int cgi_ = b * 32 + (nn), item8_ = cgi_ * 8 + h, row0_ = cgi_ * 64; \
      P##al = alast[item8_]; \
      const u16* wkp_ = Bb + (size_t)(row0_ + 16 * mt + fr) * 2048 + 1024 + h * 128 + fq * 8; \
      const u16* qdp_ = Bb + (size_t)(row0_ + 16 * mt + fr) * 2048 + h * 128 + fq * 8; \
      P##wk0 = *(const bf16x8*)(wkp_); P##wk1 = *(const bf16x8*)(wkp_ + 32); P##wk2 = *(const bf16x8*)(wkp_ + 64); P##wk3 = *(const bf16x8*)(wkp_ + 96); \
      P##qd0 = *(const bf16x8*)(qdp_); P##qd1 = *(const bf16x8*)(qdp_ + 32); P##qd2 = *(const bf16x8*)(qdp_ + 64); P##qd3 = *(const bf16x8*)(qdp_ + 96); \
      const u16* qkp_ = QK + (size_t)item8_ * 4096 + (16 * mt + fr) * 64 + fq * 8; \
      P##qk0 = *(const bf16x8*)(qkp_); P##qk1 = *(const bf16x8*)(qkp_ + 32); \
      const u16* ktp_ = KTT + (size_t)item8_ * 8192 + (wid * 16 + fr) * 64 + fq * 8; \
      P##kt0 = *(const bf16x8*)(ktp_); P##kt1 = *(const bf16x8*)(ktp_ + 32); \
      const u16* upl_ = Cb + (size_t)(row0_ + 16 * mt + fq * 4) * 2048 + h * 128 + sl * 32 + nt * 16 + fr; \
      P##uu[0] = bf2f(upl_[0]); P##uu[1] = bf2f(upl_[2048]); P##uu[2] = bf2f(upl_[4096]); P##uu[3] = bf2f(upl_[6144]); \
    } while (0)
#define MFMA16(a, b, c) __builtin_amdgcn_mfma_f32_16x16x32_bf16((a), (b), (c), 0, 0, 0)
    SCAN_DECL(c_);
    SCAN_LOAD_OPS(0, c_);
#pragma unroll 1
    for (int n = 0; n < 32; ++n) {
      const int row0 = (b * 32 + n) * 64;
      SCAN_DECL(n_);
      SCAN_LOAD_OPS((n < 31 ? n + 1 : n), n_);
      u16* up = Cb + (size_t)(row0 + 16 * mt + fq * 4) * 2048 + h * 128 + sl * 32 + nt * 16 + fr;
      const u16* stp = ST + (nt * 16 + fr) * 136 + fq * 8;
      const bf16x8 bs0 = *(const bf16x8*)(stp), bs1 = *(const bf16x8*)(stp + 32), bs2 = *(const bf16x8*)(stp + 64), bs3 = *(const bf16x8*)(stp + 96);
      f32x4 aw = f32x4{0.f, 0.f, 0.f, 0.f};
      aw = MFMA16(c_wk0, bs0, aw); aw = MFMA16(c_wk1, bs1, aw); aw = MFMA16(c_wk2, bs2, aw); aw = MFMA16(c_wk3, bs3, aw);
      {
        uint2 pk;
        pk.x = pack2(c_uu[0] - aw[0], c_uu[1] - aw[1]);
        pk.y = pack2(c_uu[2] - aw[2], c_uu[3] - aw[3]);
        *(uint2*)(WT + (nt * 16 + fr) * 72 + 16 * mt + fq * 4) = pk;
      }
      lds_barrier();
      const u16* wtp = WT + fr * 72 + fq * 8;
      const bf16x8 bw00 = *(const bf16x8*)(wtp), bw01 = *(const bf16x8*)(wtp + 32);
      const bf16x8 bw10 = *(const bf16x8*)(wtp + 16 * 72), bw11 = *(const bf16x8*)(wtp + 16 * 72 + 32);
      f32x4 ao = f32x4{0.f, 0.f, 0.f, 0.f};
      ao = MFMA16(c_qd0, bs0, ao); ao = MFMA16(c_qd1, bs1, ao); ao = MFMA16(c_qd2, bs2, ao); ao = MFMA16(c_qd3, bs3, ao);
      ao = MFMA16(c_qk0, nt ? bw10 : bw00, ao); ao = MFMA16(c_qk1, nt ? bw11 : bw01, ao);
#pragma unroll
      for (int j = 0; j < 4; ++j) {
        const float s2 = sum16(ao[j] * ao[j]);
        if (fr == 0) atomicAdd(&oss[(size_t)(row0 + 16 * mt + fq * 4 + j) * 8 + h], s2);
        up[(size_t)j * 2048] = f2bf(ao[j]);
      }
      f32x4 s0 = S0v * c_al, s1 = S1v * c_al;
      s0 = MFMA16(c_kt0, bw00, s0); s0 = MFMA16(c_kt1, bw01, s0);
      s1 = MFMA16(c_kt0, bw10, s1); s1 = MFMA16(c_kt1, bw11, s1);
      S0v = s0; S1v = s1;
      {
        uint2 pk;
        pk.x = pack2(s0[0], s0[1]); pk.y = pack2(s0[2], s0[3]);
        *(uint2*)(ST + fr * 136 + wid * 16 + fq * 4) = pk;
        pk.x = pack2(s1[0], s1[1]); pk.y = pack2(s1[2], s1[3]);
        *(uint2*)(ST + (16 + fr) * 136 + wid * 16 + fq * 4) = pk;
      }
      lds_barrier();
      c_wk0 = n_wk0; c_wk1 = n_wk1; c_wk2 = n_wk2; c_wk3 = n_wk3; c_qd0 = n_qd0; c_qd1 = n_qd1; c_qd2 = n_qd2; c_qd3 = n_qd3;
      c_qk0 = n_qk0; c_qk1 = n_qk1; c_kt0 = n_kt0; c_kt1 = n_kt1; c_uu = n_uu; c_al = n_al;
    }
    float* dst = p.out + O_DNP + (size_t)(b * 8 + h) * 16384;
#pragma unroll
    for (int j = 0; j < 4; ++j) {
      dst[(wid * 16 + fq * 4 + j) * 128 + sl * 32 + fr] = S0v[j];
      dst[(wid * 16 + fq * 4 + j) * 128 + sl * 32 + 16 + fr] = S1v[j];
    }
  }
}
DI void phase_final(const Params& p, const int gtid, const int gn) {
  char* ws = p.ws;
  const float* sumsq = (const float*)(ws + W_STAT) + (size_t)4 * T;
  const float* gain = p.in[30];
  float* y = p.out + O_Y;
  for (int base = gtid; base < T * 256; base += 8 * gn) {
    f32x4 v[8]; float rs[8]; f32x4 g[8];
#pragma unroll
    for (int u = 0; u < 8; ++u) {
      const int i = base + u * gn;
      if (i < T * 256) {
        const int row = i >> 8, c = (i & 255) * 4;
        v[u] = *(const f32x4*)(y + (size_t)row * 1024 + c);
        rs[u] = sumsq[row];
        g[u] = *(const f32x4*)(gain + c);
      }
    }
#pragma unroll
    for (int u = 0; u < 8; ++u) {
      const int i = base + u * gn;
      if (i < T * 256) {
        const int row = i >> 8, c = (i & 255) * 4;
        const float r = rsqrtf(rs[u] * (1.f / 1024.f) + EPS);
        f32x4 o;
#pragma unroll
        for (int q = 0; q < 4; ++q) o[q] = v[u][q] * r * g[u][q];
        *(f32x4*)(y + (size_t)row * 1024 + c) = o;
      }
    }
  }
  const float* S0 = p.in[4];
  const float* wss = (const float*)(ws + W_WSS);
  const float* kss = (const float*)(ws + W_KSS);
  const float* egs = (const float*)(ws + W_EGS);
  float* dS = p.out + O_DNS;
  for (int base = gtid; base < 1024 * 4096; base += 8 * gn) {
    f32x4 sv[8];
#pragma unroll
    for (int u = 0; u < 8; ++u) { const int i = base + u * gn; if (i < 1024 * 4096) sv[u] = *(const f32x4*)(S0 + (size_t)i * 4); }
#pragma unroll
    for (int u = 0; u < 8; ++u) {
      const int i = base + u * gn;
      if (i < 1024 * 4096) {
        const int it = i >> 12, dk = (i >> 5) & 127, dv = (i & 31) * 4;
        const float eg = egs[it], kv = kss[it * 128 + dk];
        const f32x4 w = *(const f32x4*)(wss + it * 128 + dv);
        f32x4 o;
#pragma unroll
        for (int q = 0; q < 4; ++q) o[q] = eg * sv[u][q] + kv * w[q];
        *(f32x4*)(dS + (size_t)i * 4) = o;
      }
    }
  }
}

DI void grid_barrier(unsigned* bar, int bid, int nb, unsigned k, int tid) {
  __syncthreads();
  if (tid == 0) {
    __threadfence();
    unsigned* gc = bar + (bid & 7) * 64;
    unsigned* top = bar + 8 * 64;
    const unsigned gsz = (unsigned)nb >> 3;
    const unsigned old = __hip_atomic_fetch_add(gc, 1u, __ATOMIC_RELAXED, __HIP_MEMORY_SCOPE_AGENT);
    if (old == gsz * k - 1u) __hip_atomic_fetch_add(top, 1u, __ATOMIC_RELAXED, __HIP_MEMORY_SCOPE_AGENT);
    while (__hip_atomic_load(top, __ATOMIC_RELAXED, __HIP_MEMORY_SCOPE_AGENT) < 8u * k) __builtin_amdgcn_s_sleep(1);
    __threadfence();
  }
  __syncthreads();
}

__global__ void __launch_bounds__(512) mega(Params p, int ph_lo, int ph_hi, int coop) {
  __shared__ __attribute__((aligned(16))) char smem[LDS_BYTES];
  const int nb = gridDim.x;
  const int bid = blockIdx.x;
  const int vb = ((nb & 7) == 0) ? ((bid & 7) * (nb >> 3) + (bid >> 3)) : bid;
#pragma unroll 1
  for (int ph = ph_lo; ph < ph_hi; ++ph) {
    Params q = p;
    int vbl = vb, nbl = nb, bidl = bid;
    long zoff = 0;
    asm volatile("" : "+s"(zoff), "+s"(vbl), "+s"(nbl), "+s"(bidl));
    q.ws = p.ws + zoff; q.out = p.out + zoff;
    const int tid = TID();
    const int sub = tid >> 8, tid2 = tid & 255;
    const int vsb = vbl * 2 + sub, nsb = nbl * 2;
    switch (ph) {
      case 0: if (PH_MASK & (1 << 0)) phase_prep(q, smem, sub, tid2, vsb, nsb); break;
      case 1: if (PH_MASK & (1 << 1)) phase_inproj<0>(q, smem, tid, bidl, nbl, 0); break;
      case 2: if (PH_MASK & (1 << 2)) phase_poolpass(q, vbl * 512 + tid, nbl * 512, 0); break;
      case 3: if (PH_MASK & (1 << 3)) phase_poolgrp(q, smem, tid, bidl, nbl, 0); break;
      case 4: if (PH_MASK & (1 << 4)) phase_outproj(q, smem, tid, bidl, nbl, 0, 1); break;
      case 5: if (PH_MASK & (1 << 5)) phase_inproj<1>(q, smem, tid, bidl, nbl, 1); break;
      case 6: if (PH_MASK & (1 << 6)) phase_spatial(q, smem, sub, tid2, vsb, nsb); break;
      case 7: if (PH_MASK & (1 << 7)) phase_outproj(q, smem, tid, bidl, nbl, 1, 0); break;
      case 8: if (PH_MASK & (1 << 8)) phase_inproj<2>(q, smem, tid, bidl, nbl, 2); break;
      case 9: if (PH_MASK & (1 << 9)) phase_chunkprep(q, smem, sub, tid2, vsb, nsb); break;
      case 10: if (PH_MASK & (1 << 10)) phase_scan(q, smem, tid, bidl, nbl); break;
      case 11: if (PH_MASK & (1 << 11)) phase_ogate(q, vbl * 512 + tid, nbl * 512); break;
      case 12: if (PH_MASK & (1 << 12)) phase_outproj(q, smem, tid, bidl, nbl, 2, 2); break;
      case 13: if (PH_MASK & (1 << 13)) phase_inproj<0>(q, smem, tid, bidl, nbl, 3); break;
      case 14: if (PH_MASK & (1 << 14)) phase_poolpass(q, vbl * 512 + tid, nbl * 512, 3); break;
      case 15: if (PH_MASK & (1 << 15)) phase_poolgrp(q, smem, tid, bidl, nbl, 3); break;
      case 16: if (PH_MASK & (1 << 16)) phase_outproj(q, smem, tid, bidl, nbl, 3, 1); break;
      case 17: if (PH_MASK & (1 << 17)) phase_final(q, vbl * 512 + tid, nbl * 512); break;
      default: break;
    }
    if (coop && ph + 1 < ph_hi) {
      if (ph == ph_lo) cg::this_grid().sync();
      else grid_barrier((unsigned*)(p.ws + W_BAR), bid, nb, (unsigned)(ph - ph_lo), TID());
    }
  }
}

extern "C" void kernel_launch(void* const* d_in, const int* in_sizes, int n_in, void* d_out, int out_size, void* d_ws,
                              size_t ws_size, hipStream_t stream) {
  static int grid_blocks = 0;
  if (!grid_blocks) {
    int dev = 0, cus = 0, per_cu = 0;
    (void)hipGetDevice(&dev);
    (void)hipDeviceGetAttribute(&cus, hipDeviceAttributeMultiprocessorCount, dev);
    (void)hipOccupancyMaxActiveBlocksPerMultiprocessor(&per_cu, mega, 512, 0);
    if (per_cu < 1) fprintf(stderr, "occupancy query returned %d\n", per_cu);
    grid_blocks = cus;
  }
  Params p{};
  for (int i = 0; i < 31; ++i) p.in[i] = (const float*)d_in[i];
  p.out = (float*)d_out;
  p.ws = (char*)d_ws;
  if (ws_size < W_END) { fprintf(stderr, "workspace too small: %zu < %zu\n", ws_size, (size_t)W_END); }
#if MULTI_LAUNCH
  for (int ph = 0; ph < NPHASE; ++ph) {
    for (int rep = 0; rep < 1 + ((DUP_MASK >> ph) & 1); ++rep)
      hipLaunchKernelGGL(mega, dim3(grid_blocks), dim3(512), 0, stream, p, ph, ph + 1, 0);
  }
#else
  (void)hipMemsetAsync((char*)d_ws + W_BAR, 0, 4096, stream);
  int lo = 0, hi = NPHASE, coop = 1;
  void* args[] = {&p, &lo, &hi, &coop};
  hipError_t e = hipLaunchCooperativeKernel((void*)mega, dim3(grid_blocks), dim3(512), args, 0, stream);
  if (e != hipSuccess) fprintf(stderr, "cooperative launch failed: %s (grid %d)\n", hipGetErrorString(e), grid_blocks);
#endif
}
```

```cpp
#include <hip/hip_runtime.h>
#include <hip/hip_cooperative_groups.h>
#include <cstdio>
namespace cg = cooperative_groups;

#ifndef PH_MASK
#define PH_MASK 0x3ffff
#endif
#ifndef DUP_MASK
#define DUP_MASK 0
#endif
#ifndef MULTI_LAUNCH
#define MULTI_LAUNCH 0
#endif

typedef unsigned short u16;
using bf16x8 = __attribute__((ext_vector_type(8))) short;
using f32x4 = __attribute__((ext_vector_type(4))) float;
#define DI __device__ __forceinline__

constexpr int T = 16512;
constexpr int TP = 16384;
constexpr float EPS = 1e-6f;
constexpr int NPHASE = 18;
constexpr int LDS_SUB = 73728;
constexpr int LDS_BYTES = 2 * LDS_SUB;

constexpr size_t O_Y = 0;
constexpr size_t O_POOL0P = (size_t)T * 1024;
constexpr size_t O_POOL0S = O_POOL0P + 8 * 15 * 2048;
constexpr size_t O_SGUV = O_POOL0S + 128 * 15 * 2048;
constexpr size_t O_CONVP = O_SGUV + 128 * 2048;
constexpr size_t O_CONVS = O_CONVP + 8 * 3 * 3072;
constexpr size_t O_DNP = O_CONVS + 128 * 3 * 3072;
constexpr size_t O_DNS = O_DNP + 8 * 8 * 128 * 128;
constexpr size_t O_POOL3P = O_DNS + (size_t)128 * 8 * 128 * 128;
constexpr size_t O_POOL3S = O_POOL3P + 8 * 15 * 2048;

constexpr size_t W_0IN = 0;
constexpr size_t W_0GRP = W_0IN + (size_t)4096 * 1024 * 2;
constexpr size_t W_0OUT = W_0GRP + (size_t)4 * 512 * 512 * 2;
constexpr size_t W_1IN = W_0OUT + (size_t)1024 * 2048 * 2;
constexpr size_t W_1WS = W_1IN + (size_t)6144 * 1024 * 2;
constexpr size_t W_1OUT = W_1WS + (size_t)4 * 128 * 128 * 2;
constexpr size_t W_2IN = W_1OUT + (size_t)1024 * 2048 * 2;
constexpr size_t W_2OUT = W_2IN + (size_t)4224 * 1024 * 2;
constexpr size_t W_3IN = W_2OUT + (size_t)1024 * 1024 * 2;
constexpr size_t W_3GRP = W_3IN + (size_t)4096 * 1024 * 2;
constexpr size_t W_3OUT = W_3GRP + (size_t)4 * 512 * 512 * 2;
constexpr size_t W_A = W_3OUT + (size_t)1024 * 2048 * 2;
constexpr size_t ABC = (size_t)T * 2048 * 2;
constexpr size_t W_B = W_A + ABC;
constexpr size_t W_C = W_B + ABC;
constexpr size_t W_STAT = W_C + ABC;
constexpr size_t W_G = W_STAT + (size_t)15 * T * 4;
constexpr size_t W_BETA = W_G + (size_t)T * 8 * 4;
constexpr size_t W_ALAST = W_BETA + (size_t)T * 8 * 4;
constexpr size_t W_WSS = W_ALAST + 2048 * 4;
constexpr size_t W_KSS = W_WSS + 128 * 8 * 128 * 4;
constexpr size_t W_EGS = W_KSS + 128 * 8 * 128 * 4;
constexpr size_t W_BAR = W_EGS + 128 * 8 * 4;
constexpr size_t W_END = W_BAR + 4096;
constexpr size_t A_HALO = 0;
constexpr size_t A_KTT = A_HALO + (size_t)256 * 3 * 3072 * 2;
constexpr size_t A_QK = A_KTT + (size_t)2048 * 8192 * 2;

struct Params {
  const float* in[31];
  float* out;
  char* ws;
};

DI int TID() { int t = threadIdx.x; asm volatile("" : "+v"(t)); return t; }
DI float bf2f(u16 x) { return __uint_as_float(((unsigned)x) << 16); }
typedef __bf16 bf16v2_t __attribute__((ext_vector_type(2)));
typedef float f32v2_t __attribute__((ext_vector_type(2)));
DI unsigned pack2(float a, float b) {
  f32v2_t f = {a, b};
  bf16v2_t h = __builtin_convertvector(f, bf16v2_t);
  return __builtin_bit_cast(unsigned, h);
}
DI u16 f2bf(float x) { return (u16)(pack2(x, 0.f) & 0xffffu); }
DI void unpack8(const uint4& u, float* f) {
  f[0] = __uint_as_float(u.x << 16); f[1] = __uint_as_float(u.x & 0xffff0000u);
  f[2] = __uint_as_float(u.y << 16); f[3] = __uint_as_float(u.y & 0xffff0000u);
  f[4] = __uint_as_float(u.z << 16); f[5] = __uint_as_float(u.z & 0xffff0000u);
  f[6] = __uint_as_float(u.w << 16); f[7] = __uint_as_float(u.w & 0xffff0000u);
}
DI uint4 pack8(const float* f) {
  uint4 u;
  u.x = pack2(f[0], f[1]); u.y = pack2(f[2], f[3]); u.z = pack2(f[4], f[5]); u.w = pack2(f[6], f[7]);
  return u;
}
DI void lds_barrier() {
  asm volatile("s_waitcnt lgkmcnt(0)" ::: "memory");
  __builtin_amdgcn_s_barrier();
  asm volatile("" ::: "memory");
}
DI float sigm_f(float x) { return __builtin_amdgcn_rcpf(1.f + __expf(-x)); }
DI float silu_f(float x) { return x * sigm_f(x); }
DI float gelu_f(float v) {
  const float av = fabsf(v);
  const float t = __builtin_amdgcn_rcpf(av * 0.2316418882f + 1.0f);
  float q = t * 0.5307027145f + (-0.7265760135f);
  q = q * t + 0.7107068705f; q = q * t + (-0.142248368f); q = q * t + 0.127414796f; q = q * t;
  const float e = __builtin_amdgcn_exp2f((v * v) * (-0.72134752044f));
  const float m = v * (q * e);
  return v < 0.f ? m : v - m;
}
DI float wave_sum(float v) {
#pragma unroll
  for (int o = 32; o > 0; o >>= 1) v += __shfl_xor(v, o, 64);
  return v;
}
DI float sum8(float v) {
  v += __shfl_xor(v, 1, 64); v += __shfl_xor(v, 2, 64); v += __shfl_xor(v, 4, 64);
  return v;
}
DI float sum16(float v) {
  v += __shfl_xor(v, 1, 64); v += __shfl_xor(v, 2, 64); v += __shfl_xor(v, 4, 64); v += __shfl_xor(v, 8, 64);
  return v;
}

template <class AL, class BL, class EP>
DI void gemm_tile(char* smem, const int tid, int nk, AL aload, BL bload, EP epi) {
  const int lane = tid & 63, wid = tid >> 6;
  const int wr = wid >> 1, wc = wid & 1, fr = lane & 15, fq = lane >> 4;
  f32x4 acc[4][4];
#pragma unroll
  for (int m = 0; m < 4; ++m)
#pragma unroll
    for (int n = 0; n < 4; ++n) acc[m][n] = f32x4{0.f, 0.f, 0.f, 0.f};
  const int crow = tid >> 3, ck = (tid & 7) * 8;
  uint4 ra[4], rb[4];
#pragma unroll
  for (int i = 0; i < 4; ++i) { ra[i] = aload(crow + 32 * i, ck); rb[i] = bload(crow + 32 * i, ck); }
  __syncthreads();
#pragma unroll
  for (int i = 0; i < 4; ++i) {
    *(uint4*)(smem + (crow + 32 * i) * 144 + ck * 2) = ra[i];
    *(uint4*)(smem + 18432 + (crow + 32 * i) * 144 + ck * 2) = rb[i];
  }
  __syncthreads();
  for (int kt = 0; kt < nk; ++kt) {
    const int cur = kt & 1;
    const bool more = (kt + 1 < nk);
    if (more) {
#pragma unroll
      for (int i = 0; i < 4; ++i) { ra[i] = aload(crow + 32 * i, (kt + 1) * 64 + ck); rb[i] = bload(crow + 32 * i, (kt + 1) * 64 + ck); }
    }
    const char* As = smem + cur * 36864;
    const char* Bs = As + 18432;
#pragma unroll
    for (int ks = 0; ks < 2; ++ks) {
      bf16x8 a[4], b[4];
#pragma unroll
      for (int m = 0; m < 4; ++m) a[m] = *(const bf16x8*)(As + (wr * 64 + m * 16 + fr) * 144 + ks * 64 + fq * 16);
#pragma unroll
      for (int n = 0; n < 4; ++n) b[n] = *(const bf16x8*)(Bs + (wc * 64 + n * 16 + fr) * 144 + ks * 64 + fq * 16);
#pragma unroll
      for (int m = 0; m < 4; ++m)
#pragma unroll
        for (int n = 0; n < 4; ++n) acc[m][n] = __builtin_amdgcn_mfma_f32_16x16x32_bf16(a[m], b[n], acc[m][n], 0, 0, 0);
    }
    if (more) {
      char* Ad = smem + (cur ^ 1) * 36864;
#pragma unroll
      for (int i = 0; i < 4; ++i) {
        *(uint4*)(Ad + (crow + 32 * i) * 144 + ck * 2) = ra[i];
        *(uint4*)(Ad + 18432 + (crow + 32 * i) * 144 + ck * 2) = rb[i];
      }
    }
    __syncthreads();
  }
  float* st = (float*)(smem + wid * 17408);
#pragma unroll
  for (int m = 0; m < 4; ++m)
#pragma unroll
    for (int n = 0; n < 4; ++n)
#pragma unroll
      for (int j = 0; j < 4; ++j) st[(m * 16 + fq * 4 + j) * 68 + n * 16 + fr] = acc[m][n][j];
  __syncthreads();
#pragma unroll
  for (int i = 0; i < 8; ++i) {
    const int r = (lane >> 3) + 8 * i, c = (lane & 7) * 8;
    f32x4 v0 = *(const f32x4*)(st + r * 68 + c);
    f32x4 v1 = *(const f32x4*)(st + r * 68 + c + 4);
    epi(wr * 64 + r, wc * 64 + c, v0, v1);
  }
}

DI void store8bf(u16* dst, const float* v) { *(uint4*)dst = pack8(v); }
DI void store8f(float* dst, const float* v) {
  *(f32x4*)dst = f32x4{v[0], v[1], v[2], v[3]};
  *(f32x4*)(dst + 4) = f32x4{v[4], v[5], v[6], v[7]};
}


namespace pg8 {
#define PG8_LAS __attribute__((address_space(3)))
typedef unsigned short bf16_t;
typedef short bf16x8 __attribute__((ext_vector_type(8)));
typedef float f32x4 __attribute__((ext_vector_type(4)));
typedef unsigned u32x4 __attribute__((ext_vector_type(4)));
constexpr int BM = 256, BK = 64, HALF = 128, HTB = HALF * BK * 2  , STAGE_BYTES = 8 * HTB, NXCD = 8, WGM = 8;

__host__ __device__ __forceinline__ int lds_byte(int r, int c) { const int st = (r >> 4) * 2 + (c >> 5), rr = r & 15, cc = c & 31, ob = rr * 64 + cc * 2; return st * 1024 + (ob ^ (((ob >> 9) & 1) << 5)); }
__host__ __device__ __forceinline__ void stage_rc(int b, int& R, int& C) { const int st = b / 1024, sb = b % 1024, swz = sb ^ (((sb >> 9) & 1) << 5); R = (st >> 1) * 16 + swz / 64; C = (st & 1) * 32 + (swz % 64) / 2; }
__host__ __device__ __forceinline__ int perm32(int rho) { const int n = rho >> 4, i = rho & 15; return 8 * (i >> 2) + 4 * n + (i & 3); }

struct Unit { int pm, pn; };
struct Gemm { const bf16_t* A; const bf16_t* Bt; int lda, ldb, K, grp_shift; size_t grp_astride; };

struct StaticOrder {
    int nM, nN, nwg, G, c;
    __host__ __device__ void init(int M, int N, int G_, int c_) { nM = M / BM; nN = N / BM; nwg = nM * nN; G = G_; c = c_; }
    __host__ __device__ bool next(int i, Unit& u) const {
        const long L = (long)i * G + c; if (L >= nwg) return false;
        int wgid = (int)L; { const int q = nwg / NXCD, r = nwg % NXCD, xcd = wgid % NXCD, off = wgid / NXCD; wgid = (xcd < r ? xcd * (q + 1) : r * (q + 1) + (xcd - r) * q) + off; }
        const int nig = WGM * nN, gid = wgid / nig, fm = gid * WGM, gsz = (nM - fm) < WGM ? (nM - fm) : WGM;
        u.pm = fm + ((wgid % nig) % gsz); u.pn = (wgid % nig) / gsz; return true;
    }
    __device__ __forceinline__ void a_ready(const Unit&) const {}
    __device__ __forceinline__ void done(const Unit&) const {}
};

template <class Epi, class Sched, bool STAMP = false>
__device__ __forceinline__ void gemm_phase(PG8_LAS unsigned char* lds, const int tid, const Gemm g, const Sched& S, const Epi& E, unsigned long long* stamps) {
    const int wid = __builtin_amdgcn_readfirstlane(tid >> 6), lane = tid & 63, wr = wid >> 2, wc = wid & 3, fr = lane & 15, fq = lane >> 4;
    const int K = g.K, nt = K / BK;
    int ts_lo = 0, ts_hi = 0, nts = 0; const unsigned long long rt_entry = STAMP ? (unsigned long long)wall_clock64() : 0ull;
#define PG8_STAMP() do { if (STAMP && wid == 0 && nts < 64) { const unsigned long long _c = (unsigned long long)clock64(); \
        ts_lo = (lane == nts) ? (int)(unsigned)_c : ts_lo; ts_hi = (lane == nts) ? (int)(unsigned)(_c >> 32) : ts_hi; ++nts; } } while (0)
    PG8_STAMP();
    unsigned voffA[2], voffB[2];
#pragma unroll
    for (int i = 0; i < 2; ++i) { int R, C; stage_rc(tid * 16 + i * 8192, R, C); const int Rb = Epi::PERM ? ((R & ~31) + perm32(R & 31)) : R;
        voffA[i] = (unsigned)(R * g.lda + C) * 2u; voffB[i] = (unsigned)(Rb * g.ldb + C) * 2u; }
    const size_t kstep = (size_t)(BK * 2);
    const size_t hstepA = (size_t)HALF * g.lda * 2, hstepB = (size_t)HALF * g.ldb * 2;
    const size_t tstepA = 2 * hstepA, tstepB = 2 * hstepB;
    const unsigned ldsw = (unsigned)wid * 1024u;
    const int aoff = lds_byte(wr * 64 + fr, fq * 8), boff = lds_byte(wc * 32 + fr, fq * 8);
#define PG8_SA(b, h) (((b) * 2 + (h)) * HTB)
#define PG8_SB(b, h) ((4 + (b) * 2 + (h)) * HTB)
#define PG8_STAGE(bufoff, gbase, voff) do { _Pragma("unroll") for (int _i = 0; _i < 2; ++_i) \
        __builtin_amdgcn_global_load_lds((const unsigned*)((const char*)(gbase) + (voff)[_i]), (PG8_LAS unsigned*)(lds + (bufoff) + ldsw + _i * 8192), 16, 0, 0); } while (0)
#define PG8_LDA(dst, b, h) do { _Pragma("unroll") for (int m = 0; m < 4; ++m) _Pragma("unroll") for (int k = 0; k < 2; ++k) dst[m][k] = *(const PG8_LAS bf16x8*)(lds + PG8_SA(b, h) + aoff + m * 2048 + k * 1024); } while (0)
#define PG8_LDB(dst, b, h) do { _Pragma("unroll") for (int n = 0; n < 2; ++n) _Pragma("unroll") for (int k = 0; k < 2; ++k) dst[n][k] = *(const PG8_LAS bf16x8*)(lds + PG8_SB(b, h) + boff + n * 2048 + k * 1024); } while (0)
#define PG8_MMA(ai, bj, At, Bt) do { __builtin_amdgcn_s_setprio(1); _Pragma("unroll") for (int m = 0; m < 4; ++m) _Pragma("unroll") for (int n = 0; n < 2; ++n) _Pragma("unroll") for (int k = 0; k < 2; ++k) \
        acc[ai][bj][m][n] = __builtin_amdgcn_mfma_f32_16x16x32_bf16(Bt[n][k], At[m][k], acc[ai][bj][m][n], 0, 0, 0); __builtin_amdgcn_s_setprio(0); } while (0)
#define PG8_WAIT_V(n) asm volatile("s_waitcnt vmcnt(" #n ")" ::: "memory")
#define PG8_WAIT_L(n) asm volatile("s_waitcnt lgkmcnt(" #n ")" ::: "memory")
#define PG8_BAR __builtin_amdgcn_s_barrier()
#define PG8_SCHED __builtin_amdgcn_sched_barrier(0)
    Unit cur, nxt; int ui = 0;
    if (!S.next(0, cur)) return;
    f32x4 acc[2][2][4][2];
#pragma unroll
    for (int a = 0; a < 2; ++a)
#pragma unroll
        for (int b = 0; b < 2; ++b)
#pragma unroll
            for (int m = 0; m < 4; ++m)
#pragma unroll
                for (int n = 0; n < 2; ++n) acc[a][b][m][n] = (f32x4){0.f, 0.f, 0.f, 0.f};
    bf16x8 At[4][2], B0[2][2], B1[2][2];
    const char* cA = (const char*)g.A + (size_t)cur.pm * tstepA + (size_t)(cur.pn >> g.grp_shift) * g.grp_astride; const char* cB = (const char*)g.Bt + (size_t)cur.pn * tstepB;
    S.a_ready(cur);
    PG8_STAGE(PG8_SB(0, 0), cB, voffB); PG8_STAGE(PG8_SA(0, 0), cA, voffA); PG8_STAGE(PG8_SB(0, 1), cB + hstepB, voffB); PG8_STAGE(PG8_SA(0, 1), cA + hstepA, voffA);
    if (wr == 1) PG8_BAR;
    PG8_WAIT_V(4); PG8_BAR;
    PG8_STAGE(PG8_SB(1, 0), cB + kstep, voffB); PG8_STAGE(PG8_SA(1, 0), cA + kstep, voffA); PG8_STAGE(PG8_SB(1, 1), cB + hstepB + kstep, voffB);
    PG8_WAIT_V(6); PG8_BAR;
    PG8_STAMP();
    for (;;) {
        const bool has_next = S.next(ui + 1, nxt);
        const char* nA = has_next ? (const char*)g.A + (size_t)nxt.pm * tstepA + (size_t)(nxt.pn >> g.grp_shift) * g.grp_astride : cA; const char* nB = has_next ? (const char*)g.Bt + (size_t)nxt.pn * tstepB : cB;
        for (int t = 0; t < nt; t += 2) {
            const bool last = (t == nt - 2);
            const char* a1 = cA + (size_t)(t + 1) * kstep;
            const char* a2 = last ? nA : cA + (size_t)(t + 2) * kstep; const char* b2 = last ? nB : cB + (size_t)(t + 2) * kstep;
            const char* a3 = a2 + kstep; const char* b3 = b2 + kstep;
            if (last && has_next) S.a_ready(nxt);
            PG8_LDB(B0, 0, 0); PG8_SCHED; PG8_LDA(At, 0, 0); PG8_STAGE(PG8_SA(1, 1), a1 + hstepA, voffA);
            PG8_WAIT_L(8); PG8_BAR; PG8_WAIT_L(0); PG8_MMA(0, 0, At, B0); PG8_BAR; PG8_SCHED;
            PG8_LDB(B1, 0, 1); PG8_STAGE(PG8_SB(0, 0), b2, voffB);
            PG8_BAR; PG8_WAIT_L(0); PG8_MMA(0, 1, At, B1); PG8_BAR;
            PG8_LDA(At, 0, 1); PG8_STAGE(PG8_SA(0, 0), a2, voffA);
            PG8_BAR; PG8_WAIT_L(0); PG8_MMA(1, 0, At, B0); PG8_BAR; PG8_SCHED;
            PG8_STAGE(PG8_SB(0, 1), b2 + hstepB, voffB);
            PG8_WAIT_V(6); PG8_BAR; PG8_MMA(1, 1, At, B1); PG8_BAR;
            PG8_LDB(B0, 1, 0); PG8_SCHED; PG8_LDA(At, 1, 0); PG8_STAGE(PG8_SA(0, 1), a2 + hstepA, voffA);
            PG8_WAIT_L(8); PG8_BAR; PG8_WAIT_L(0); PG8_MMA(0, 0, At, B0); PG8_BAR; PG8_SCHED;
            PG8_LDB(B1, 1, 1); PG8_STAGE(PG8_SB(1, 0), b3, voffB);
            PG8_BAR; PG8_WAIT_L(0); PG8_MMA(0, 1, At, B1); PG8_BAR;
            PG8_LDA(At, 1, 1); PG8_STAGE(PG8_SA(1, 0), a3, voffA);
            PG8_BAR; PG8_WAIT_L(0); PG8_MMA(1, 0, At, B0); PG8_BAR; PG8_SCHED;
            PG8_STAGE(PG8_SB(1, 1), b3 + hstepB, voffB);
            PG8_WAIT_V(6); PG8_BAR; PG8_MMA(1, 1, At, B1); PG8_BAR;
        }
        PG8_STAMP();
        if constexpr (!Epi::AFTER_DRAIN) { E(acc, cur, wr, wc, fr, fq); S.done(cur); }
        PG8_STAMP();
        if (!has_next) break;
#pragma unroll
        for (int a = 0; a < 2; ++a)
#pragma unroll
            for (int b = 0; b < 2; ++b)
#pragma unroll
                for (int m = 0; m < 4; ++m)
#pragma unroll
                    for (int n = 0; n < 2; ++n) acc[a][b][m][n] = (f32x4){0.f, 0.f, 0.f, 0.f};
        cur = nxt; cA = nA; cB = nB; ++ui;
    }
    PG8_WAIT_V(0);
    if (wr == 0) PG8_BAR;
    PG8_BAR;
    if constexpr (Epi::AFTER_DRAIN) { E.fused(acc, cur, wr, wc, fr, fq, lds, wid, lane); S.done(cur); }
    PG8_STAMP();
    if (STAMP && wid == 0) { stamps[lane] = lane < nts ? (((unsigned long long)(unsigned)ts_hi << 32) | (unsigned)ts_lo) : 0ull;
        if (lane == 62) stamps[62] = rt_entry; if (lane == 63) stamps[63] = (unsigned long long)wall_clock64(); }
#undef PG8_STAMP
#undef PG8_SA
#undef PG8_SB
#undef PG8_STAGE
#undef PG8_LDA
#undef PG8_LDB
#undef PG8_MMA
#undef PG8_WAIT_V
#undef PG8_WAIT_L
#undef PG8_BAR
#undef PG8_SCHED
}
}

template <class F> struct EpiWrap {
  static constexpr bool PERM = true, AFTER_DRAIN = false;
  F f;
  DI void operator()(const f32x4 (&acc)[2][2][4][2], const pg8::Unit& u, int wr, int wc, int fr, int fq) const {
    float rsv[2][4];
#pragma unroll
    for (int ai = 0; ai < 2; ++ai)
#pragma unroll
      for (int m = 0; m < 4; ++m) rsv[ai][m] = f.row_scale(u.pm * 256 + ai * 128 + wr * 64 + m * 16 + fr);
    const int colb = u.pn * 256 + wc * 32 + 8 * fq;
    typename F::Pre nx0 = f.pre(u.pm * 256 + wr * 64 + fr, colb), nx1 = f.pre(u.pm * 256 + wr * 64 + fr, colb + 128);
#pragma unroll
    for (int ai = 0; ai < 2; ++ai)
#pragma unroll
      for (int m = 0; m < 4; ++m) {
        const int row = u.pm * 256 + ai * 128 + wr * 64 + m * 16 + fr;
        const float rs = rsv[ai][m];
        const typename F::Pre cu0 = nx0, cu1 = nx1;
        if (ai * 4 + m < 7) {
          const int nr = u.pm * 256 + ((ai * 4 + m + 1) >> 2) * 128 + wr * 64 + ((ai * 4 + m + 1) & 3) * 16 + fr;
          nx0 = f.pre(nr, colb); nx1 = f.pre(nr, colb + 128);
        }
        float2 part = f.elem(row, colb, acc[ai][0][m][0], acc[ai][0][m][1], rs, cu0);
        const float2 q = f.elem(row, colb + 128, acc[ai][1][m][0], acc[ai][1][m][1], rs, cu1);
        part.x += q.x; part.y += q.y;
        f.row_done(row, part, u.pn * 256);
        if (F::SERIAL) asm volatile("" ::: "memory");
      }
  }
};

template <class F>
DI void big_gemm(char* smem, const int tid, const u16* A, int lda, const u16* Bt, int ldb, int K, int N, int grp_shift,
                 size_t grp_astride, const F& f, int vb, int nb) {
  pg8::Gemm g;
  g.A = A; g.Bt = Bt; g.lda = lda; g.ldb = ldb; g.K = K; g.grp_shift = grp_shift; g.grp_astride = grp_astride;
  pg8::StaticOrder S;
  S.init(TP, N, nb, vb);
  EpiWrap<F> E{f};
  __syncthreads();
  pg8::gemm_phase<EpiWrap<F>, pg8::StaticOrder, false>((PG8_LAS unsigned char*)smem, tid, g, S, E, nullptr);
  __syncthreads();
}

template <class F>
DI void side_gemm(char* smem, const int tid, const u16* A, int lda, const u16* Bt, int ldb, int K, int row_base, int nrg,
                  int col_base, int ncg, bool grouped, const F& f, int vb, int nb) {
  const int lane = tid & 63, wid = tid >> 6, fr = lane & 15, fq = lane >> 4;
  float* red = (float*)smem;
  const int kw = K >> 3;
  for (int t = vb; t < nrg * ncg; t += nb) {
    const int rg = t % nrg, cg = t / nrg;
    const int r0 = row_base + rg * 16, c0 = col_base + cg * 32;
    const u16* ap = A + (size_t)(r0 + fr) * lda + (grouped ? (c0 >> 9) * 512 : 0) + wid * kw + fq * 8;
    const int wc0 = c0 + 8 * (fr >> 2) + (fr & 3);
    const u16* bp0 = Bt + (size_t)wc0 * ldb + wid * kw + fq * 8;
    const u16* bp1 = bp0 + (size_t)4 * ldb;
    f32x4 a0 = f32x4{0.f, 0.f, 0.f, 0.f}, a1 = f32x4{0.f, 0.f, 0.f, 0.f};
#pragma unroll 4
    for (int k = 0; k < kw; k += 32) {
      const bf16x8 av = *(const bf16x8*)(ap + k);
      const bf16x8 b0 = *(const bf16x8*)(bp0 + k);
      const bf16x8 b1 = *(const bf16x8*)(bp1 + k);
      a0 = __builtin_amdgcn_mfma_f32_16x16x32_bf16(b0, av, a0, 0, 0, 0);
      a1 = __builtin_amdgcn_mfma_f32_16x16x32_bf16(b1, av, a1, 0, 0, 0);
    }
    __syncthreads();
    *(f32x4*)(red + (wid * 64 + lane) * 8) = a0;
    *(f32x4*)(red + (wid * 64 + lane) * 8 + 4) = a1;
    __syncthreads();
    if (wid == 0) {
      f32x4 s0 = f32x4{0.f, 0.f, 0.f, 0.f}, s1 = f32x4{0.f, 0.f, 0.f, 0.f};
#pragma unroll
      for (int w = 0; w < 8; ++w) {
        s0 += *(const f32x4*)(red + (w * 64 + lane) * 8);
        s1 += *(const f32x4*)(red + (w * 64 + lane) * 8 + 4);
      }
      const int row = r0 + fr, col = c0 + 8 * fq;
      const float rs = f.row_scale(row);
      const float2 part = f.elem(row, col, s0, s1, rs, f.pre(row, col));
      f.row_done(row, part, c0 & ~255);
    }
  }
  __syncthreads();
}

DI float2 red_fq(float2 v) {
  v.x += __shfl_xor(v.x, 16, 64); v.y += __shfl_xor(v.y, 16, 64);
  v.x += __shfl_xor(v.x, 32, 64); v.y += __shfl_xor(v.y, 32, 64);
  return v;
}

template <int KIND> struct InprojF {
  static constexpr bool SERIAL = true;
  const float* sumsq; u16 *Ab, *Bb, *Cb; float* lnstat; float *Gb, *Betab; u16* halo; float* out;
  const float *a_log, *dt_bias; size_t o_poolp, o_pools;
  typedef int Pre;
  DI Pre pre(int, int) const { return 0; }
  DI float row_scale(int row) const { return rsqrtf(sumsq[row] * (1.f / 1024.f) + EPS); }
  DI float2 elem(int row, int col, const f32x4& v0, const f32x4& v1, float rs, Pre) const {
    float v[8];
    float2 part = make_float2(0.f, 0.f);
#pragma unroll
    for (int q = 0; q < 4; ++q) { v[q] = v0[q] * rs; v[4 + q] = v1[q] * rs; }
    if (KIND == 0) {
      if (col < 2048) {
        store8bf(Bb + (size_t)row * 2048 + col, v);
        if (row < TP) {
          const int tt = row & 2047, b = row >> 11;
          if (tt >= 2033) store8f(out + o_poolp + ((size_t)(b * 15 + tt - 2033) * 2048) + col, v);
        } else {
          store8f(out + o_pools + ((size_t)((row - TP) * 15 + 14) * 2048) + col, v);
        }
      } else {
#pragma unroll
        for (int q = 0; q < 8; ++q) v[q] = silu_f(v[q]);
        store8bf(Cb + (size_t)row * 2048 + (col - 2048), v);
      }
    } else if (KIND == 1) {
      if (col < 2048) {
#pragma unroll
        for (int q = 0; q < 8; ++q) v[q] = gelu_f(v[q]);
        store8bf(Ab + (size_t)row * 2048 + col, v);
      } else if (col < 4096) {
#pragma unroll
        for (int q = 0; q < 8; ++q) { v[q] = gelu_f(v[q]); part.x += v[q]; part.y += v[q] * v[q]; }
        store8bf(Bb + (size_t)row * 2048 + (col - 2048), v);
      } else {
#pragma unroll
        for (int q = 0; q < 8; ++q) v[q] = silu_f(v[q]);
        store8bf(Cb + (size_t)row * 2048 + (col - 4096), v);
      }
    } else {
      if (col < 3072) {
        if (col < 2048) store8bf(Bb + (size_t)row * 2048 + col, v);
        else store8bf(Cb + (size_t)row * 2048 + (col - 2048), v);
        if (row < TP) {
          const int tt = row & 2047, b = row >> 11;
          if (tt >= 2045) store8f(out + O_CONVP + ((size_t)(b * 3 + tt - 2045) * 3072) + col, v);
          if ((row & 63) >= 61) store8bf(halo + ((size_t)((row >> 6) * 3 + (row & 63) - 61) * 3072) + col, v);
        } else {
          store8f(out + O_CONVS + ((size_t)((row - TP) * 3 + 2) * 3072) + col, v);
        }
      } else if (col < 4096) {
#pragma unroll
        for (int q = 0; q < 8; ++q) v[q] = silu_f(v[q]);
        store8bf(Cb + (size_t)row * 2048 + 1024 + (col - 3072), v);
      }
    }
    return part;
  }
  DI void row_done(int row, float2 part, int ucol) const {
    if (KIND == 1 && ucol >= 2048 && ucol < 4096) {
      part = red_fq(part);
      if ((__lane_id() >> 4) == 0) { atomicAdd(&lnstat[row * 2], part.x); atomicAdd(&lnstat[row * 2 + 1], part.y); }
    }
  }
};


struct GdnABF {
  static constexpr bool SERIAL = true;
  const float* sumsq; float *Gb, *Betab; const float *a_log, *dt_bias;
  typedef int Pre;
  DI Pre pre(int, int) const { return 0; }
  DI float row_scale(int row) const { return rsqrtf(sumsq[row] * (1.f / 1024.f) + EPS); }
  DI float2 elem(int row, int col, const f32x4& v0, const f32x4& v1, float rs, Pre) const {
    float v[8];
#pragma unroll
    for (int q = 0; q < 4; ++q) { v[q] = v0[q] * rs; v[4 + q] = v1[q] * rs; }
    if (col == 4096) {
#pragma unroll
      for (int q = 0; q < 8; ++q) {
        const float x = v[q] + dt_bias[q];
        const float sp = (x > 20.f) ? x : __logf(1.f + __expf(x));
        v[q] = -__expf(a_log[q]) * sp;
      }
      store8f(Gb + (size_t)row * 8, v);
    } else if (col == 4104) {
#pragma unroll
      for (int q = 0; q < 8; ++q) v[q] = sigm_f(v[q]);
      store8f(Betab + (size_t)row * 8, v);
    }
    return make_float2(0.f, 0.f);
  }
  DI void row_done(int, float2, int) const {}
};

template <int KIND>
DI void phase_inproj(const Params& p, char* smem, const int tid, int vb, int nb, int layer) {
  char* ws = p.ws;
  constexpr int N = (KIND == 0) ? 4096 : (KIND == 1 ? 6144 : 4096);
  const u16* Wt = (const u16*)(ws + (layer == 0 ? W_0IN : layer == 1 ? W_1IN : layer == 2 ? W_2IN : W_3IN));
  const u16* xb16 = (const u16*)(p.out + O_DNS);
  InprojF<KIND> f;
  f.sumsq = (const float*)(ws + W_STAT) + (size_t)layer * T;
  f.Ab = (u16*)(ws + W_A); f.Bb = (u16*)(ws + W_B); f.Cb = (u16*)(ws + W_C);
  f.lnstat = (float*)(ws + W_STAT) + (size_t)5 * T;
  f.Gb = (float*)(ws + W_G); f.Betab = (float*)(ws + W_BETA);
  f.halo = (u16*)(ws + W_A + A_HALO);
  f.out = p.out; f.a_log = p.in[21]; f.dt_bias = p.in[22];
  f.o_poolp = (layer == 0) ? O_POOL0P : O_POOL3P;
  f.o_pools = (layer == 0) ? O_POOL0S : O_POOL3S;
  big_gemm(smem, tid, xb16, 1024, Wt, 1024, 1024, N, 30, 0, f, vb, nb);
  side_gemm(smem, tid, xb16, 1024, Wt, 1024, 1024, TP, 8, 0, N / 32, false, f, vb, nb);
  if (KIND == 2) {
    GdnABF fab;
    fab.sumsq = f.sumsq; fab.Gb = f.Gb; fab.Betab = f.Betab; fab.a_log = f.a_log; fab.dt_bias = f.dt_bias;
    side_gemm(smem, tid, xb16, 1024, Wt, 1024, 1024, 0, T / 16, 4096, 1, false, fab, vb, nb);
  }
}

struct PoolgrpF {
  static constexpr bool SERIAL = false;
  u16* Bb; const u16* Cb;
  DI float row_scale(int) const { return 1.f; }
  typedef uint4 Pre;
  DI Pre pre(int row, int col) const { return *(const uint4*)(Cb + (size_t)row * 2048 + col); }
  DI float2 elem(int row, int col, const f32x4& v0, const f32x4& v1, float, const Pre& zz) const {
    float z[8], v[8];
    unpack8(zz, z);
#pragma unroll
    for (int q = 0; q < 4; ++q) { v[q] = v0[q] * z[q]; v[4 + q] = v1[q] * z[4 + q]; }
    store8bf(Bb + (size_t)row * 2048 + col, v);
    return make_float2(0.f, 0.f);
  }
  DI void row_done(int, float2, int) const {}
};
DI void phase_poolgrp(const Params& p, char* smem, const int tid, int vb, int nb, int layer) {
  char* ws = p.ws;
  const u16* Wg = (const u16*)(ws + (layer == 0 ? W_0GRP : W_3GRP));
  const u16* Ab = (const u16*)(ws + W_A);
  PoolgrpF f;
  f.Bb = (u16*)(ws + W_B); f.Cb = (const u16*)(ws + W_C);
  big_gemm(smem, tid, Ab, 2048, Wg, 512, 512, 2048, 1, (size_t)512 * 2, f, vb, nb);
  side_gemm(smem, tid, Ab, 2048, Wg, 512, 512, TP, 8, 0, 64, true, f, vb, nb);
}

struct OutprojF {
  static constexpr bool SERIAL = false;
  float* xres; u16* xb16; float* sumsq_next; const float *xp, *xs; int layer;
  DI float row_scale(int) const { return 1.f; }
  struct Pre { f32x4 a, b; };
  DI Pre pre(int row, int col) const {
    const float* xo = (layer == 0) ? ((row < TP) ? xp + (size_t)row * 1024 + col : xs + (size_t)(row - TP) * 1024 + col)
                                   : xres + (size_t)row * 1024 + col;
    Pre r; r.a = *(const f32x4*)xo; r.b = *(const f32x4*)(xo + 4);
    return r;
  }
  DI float2 elem(int row, int col, const f32x4& v0, const f32x4& v1, float, const Pre& pr) const {
    const f32x4 x0 = pr.a, x1 = pr.b;
    float v[8];
    float ss = 0.f;
#pragma unroll
    for (int q = 0; q < 4; ++q) { v[q] = x0[q] + v0[q]; v[4 + q] = x1[q] + v1[q]; }
#pragma unroll
    for (int q = 0; q < 8; ++q) ss += v[q] * v[q];
    store8f(xres + (size_t)row * 1024 + col, v);
    if (layer < 3) store8bf(xb16 + (size_t)row * 1024 + col, v);
    return make_float2(ss, 0.f);
  }
  DI void row_done(int row, float2 part, int) const {
    part = red_fq(part);
    if ((__lane_id() >> 4) == 0) atomicAdd(&sumsq_next[row], part.x);
  }
};
DI void phase_outproj(const Params& p, char* smem, const int tid, int vb, int nb, int layer, int src  ) {
  char* ws = p.ws;
  const u16* Wt = (const u16*)(ws + (layer == 0 ? W_0OUT : layer == 1 ? W_1OUT : layer == 2 ? W_2OUT : W_3OUT));
  const int KD = (src == 2) ? 1024 : 2048;
  const u16* Asrc = (const u16*)(ws + (src == 1 ? W_B : W_A));
  OutprojF f;
  f.xres = p.out + O_Y; f.xb16 = (u16*)(p.out + O_DNS);
  f.sumsq_next = (float*)(ws + W_STAT) + (size_t)(layer + 1) * T;
  f.xp = p.in[0]; f.xs = p.in[1]; f.layer = layer;
  big_gemm(smem, tid, Asrc, KD, Wt, KD, KD, 1024, 30, 0, f, vb, nb);
  side_gemm(smem, tid, Asrc, KD, Wt, KD, KD, TP, 8, 0, 32, false, f, vb, nb);
}

DI void phase_ogate(const Params& p, int gtid, int gn) {
  char* ws = p.ws;
  const u16* Cb = (const u16*)(ws + W_C);
  u16* Ao = (u16*)(ws + W_A);
  const float* oss = (const float*)(ws + W_STAT) + (size_t)7 * T;
  const float* ogain = p.in[23];
  for (int i = gtid; i < T * 128; i += gn) {
    const int row = i >> 7, k = (i & 127) * 8, h = k >> 7;
    float o[8], z[8];
    unpack8(*(const uint4*)(Cb + (size_t)row * 2048 + k), o);
    unpack8(*(const uint4*)(Cb + (size_t)row * 2048 + 1024 + k), z);
    const float rs = rsqrtf(oss[(size_t)row * 8 + h] * (1.f / 128.f) + EPS);
    const f32x4 g0 = *(const f32x4*)(ogain + (k & 127));
    const f32x4 g1 = *(const f32x4*)(ogain + (k & 127) + 4);
#pragma unroll
    for (int q = 0; q < 4; ++q) { o[q] = o[q] * rs * g0[q] * z[q]; o[4 + q] = o[4 + q] * rs * g1[q] * z[4 + q]; }
    store8bf(Ao + (size_t)row * 1024 + k, o);
  }
}

DI void transpose_flat(const float* W, int K, int N, int Npad, const float* kgain, const float* nscale, u16* Wt, int gtid, int gn) {
  const int items = (K >> 5) * Npad;
  for (int i = gtid; i < items; i += gn) {
    const int kc = i / Npad, n = i - kc * Npad, k0 = kc * 32;
    float f[32];
    if (n < N) {
      const float ns = nscale ? nscale[n] : 1.f;
#pragma unroll
      for (int q = 0; q < 32; ++q) f[q] = W[(size_t)(k0 + q) * N + n];
      if (kgain) {
#pragma unroll
        for (int q = 0; q < 32; ++q) f[q] *= kgain[k0 + q];
      }
#pragma unroll
      for (int q = 0; q < 32; ++q) f[q] *= ns;
    } else {
#pragma unroll
      for (int q = 0; q < 32; ++q) f[q] = 0.f;
    }
    u16* dst = Wt + (size_t)n * K + k0;
#pragma unroll
    for (int q = 0; q < 4; ++q) *(uint4*)(dst + q * 8) = pack8(f + q * 8);
  }
}

DI void phase_prep(const Params& p, char* smem_base, const int sub, const int tid0, int vb, int nb) {
  char* smem = smem_base + sub * LDS_SUB;
  char* ws = p.ws;
  const int gtid_t = vb * 256 + tid0, gn_t = nb * 256;
  transpose_flat(p.in[7], 1024, 4096, 4096, p.in[6], nullptr, (u16*)(ws + W_0IN), gtid_t, gn_t);
  for (int g = 0; g < 4; ++g)
    transpose_flat(p.in[8] + (size_t)g * 512 * 512, 512, 512, 512, nullptr, p.in[9] + g * 512,
                  (u16*)(ws + W_0GRP) + (size_t)g * 512 * 512, gtid_t, gn_t);
  transpose_flat(p.in[10], 2048, 1024, 1024, nullptr, nullptr, (u16*)(ws + W_0OUT), gtid_t, gn_t);
  transpose_flat(p.in[12], 1024, 6144, 6144, p.in[11], nullptr, (u16*)(ws + W_1IN), gtid_t, gn_t);
  transpose_flat(p.in[17], 2048, 1024, 1024, nullptr, nullptr, (u16*)(ws + W_1OUT), gtid_t, gn_t);
  transpose_flat(p.in[19], 1024, 4112, 4224, p.in[18], nullptr, (u16*)(ws + W_2IN), gtid_t, gn_t);
  transpose_flat(p.in[24], 1024, 1024, 1024, nullptr, nullptr, (u16*)(ws + W_2OUT), gtid_t, gn_t);
  transpose_flat(p.in[26], 1024, 4096, 4096, p.in[25], nullptr, (u16*)(ws + W_3IN), gtid_t, gn_t);
  for (int g = 0; g < 4; ++g)
    transpose_flat(p.in[27] + (size_t)g * 512 * 512, 512, 512, 512, nullptr, p.in[28] + g * 512,
                  (u16*)(ws + W_3GRP) + (size_t)g * 512 * 512, gtid_t, gn_t);
  transpose_flat(p.in[29], 2048, 1024, 1024, nullptr, nullptr, (u16*)(ws + W_3OUT), gtid_t, gn_t);

  const int gtid = vb * 256 + tid0, gn = nb * 256;
  {
    u16* w16 = (u16*)(ws + W_1WS);
    const float* wsf = p.in[15];
    for (int i = gtid; i < 4 * 128 * 128; i += gn) {
      const int jj = i & 127, ii = (i >> 7) & 127;
      w16[i] = (jj <= ii) ? f2bf(wsf[i]) : (u16)0;
    }
  }
  {
    float* st = (float*)(ws + W_STAT);
    for (int i = T + gtid; i < 15 * T; i += gn) st[i] = 0.f;
  }
  {
    u16* xb16 = (u16*)(p.out + O_DNS);
    float* sumsq = (float*)(ws + W_STAT);
    const int lane = gtid & 63;
    const int gw = gtid >> 6, nw = gn >> 6;
    for (int row0 = gw; row0 < T; row0 += 4 * nw) {
      f32x4 v[4][4];
#pragma unroll
      for (int u = 0; u < 4; ++u) {
        const int row = row0 + u * nw;
        if (row < T) {
          const float* src = (row < TP) ? p.in[0] + (size_t)row * 1024 : p.in[1] + (size_t)(row - TP) * 1024;
#pragma unroll
          for (int i = 0; i < 4; ++i) v[u][i] = *(const f32x4*)(src + (lane + 64 * i) * 4);
        }
      }
#pragma unroll
      for (int u = 0; u < 4; ++u) {
        const int row = row0 + u * nw;
        if (row < T) {
          float s = 0.f;
#pragma unroll
          for (int i = 0; i < 4; ++i) {
            const int c = (lane + 64 * i) * 4;
            const f32x4 w = v[u][i];
            s += w[0] * w[0] + w[1] * w[1] + w[2] * w[2] + w[3] * w[3];
            uint2 o; o.x = pack2(w[0], w[1]); o.y = pack2(w[2], w[3]);
            *(uint2*)(xb16 + (size_t)row * 1024 + c) = o;
          }
          s = wave_sum(s);
          if (lane == 0) sumsq[row] = s;
        }
      }
    }
  }
#pragma unroll 4
  for (int i = gtid; i < 128 * 14 * 512; i += gn) {
    const int c4 = i & 511, r = (i >> 9) % 14, b = i / (14 * 512);
    const size_t so = ((size_t)(b * 15 + r + 1) * 2048) + c4 * 4, dof = ((size_t)(b * 15 + r) * 2048) + c4 * 4;
    *(f32x4*)(p.out + O_POOL0S + dof) = *(const f32x4*)(p.in[2] + so);
    *(f32x4*)(p.out + O_POOL3S + dof) = *(const f32x4*)(p.in[5] + so);
  }
#pragma unroll 2
  for (int i = gtid; i < 128 * 2 * 768; i += gn) {
    const int c4 = i % 768, r = (i / 768) & 1, b = i / (2 * 768);
    *(f32x4*)(p.out + O_CONVS + ((size_t)(b * 3 + r) * 3072) + c4 * 4) =
        *(const f32x4*)(p.in[3] + ((size_t)(b * 3 + r + 1) * 3072) + c4 * 4);
  }
}

DI void phase_poolpass(const Params& p, const int gtid, const int gn, int layer) {
  char* ws = p.ws;
  const float* hist = p.in[layer == 0 ? 2 : 5];
  u16* Ab = (u16*)(ws + W_A);
  const u16* Bb = (const u16*)(ws + W_B);
  for (int i = gtid; i < 512 * 256; i += gn) {
    const int c = (i & 255) * 8, seg = i >> 8;
    const int row0 = seg * 32, t0 = row0 & 2047;
    const int w = 2 << (c >> 9);
    const u16* xp = Bb + (size_t)row0 * 2048 + c;
    float s[8];
#pragma unroll
    for (int q = 0; q < 8; ++q) s[q] = 0.f;
    const int lim = min(w, t0);
    for (int j = 1; j <= lim; ++j) {
      float y[8];
      unpack8(*(const uint4*)(xp - (size_t)j * 2048), y);
#pragma unroll
      for (int q = 0; q < 8; ++q) s[q] += y[q];
    }
#pragma unroll 1
    for (int r0 = 0; r0 < 32; r0 += 8) {
      uint4 xc[8], xo[8];
#pragma unroll
      for (int u = 0; u < 8; ++u) {
        xc[u] = *(const uint4*)(xp + (size_t)(r0 + u) * 2048);
        xo[u] = (t0 + r0 + u >= w) ? *(const uint4*)(xp + (size_t)(r0 + u - w) * 2048) : uint4{0u, 0u, 0u, 0u};
      }
#pragma unroll
      for (int u = 0; u < 8; ++u) {
        const int t = t0 + r0 + u;
        float x[8], y[8], o[8];
        unpack8(xc[u], x);
        unpack8(xo[u], y);
#pragma unroll
        for (int q = 0; q < 8; ++q) s[q] += x[q] - y[q];
        const float inv = 1.f / (float)min(t + 1, w);
#pragma unroll
        for (int q = 0; q < 8; ++q) o[q] = s[q] * inv - x[q];
        store8bf(Ab + (size_t)(row0 + r0 + u) * 2048 + c, o);
      }
    }
  }
  for (int i = gtid; i < 128 * 256; i += gn) {
    const int c = (i & 255) * 8, b = i >> 8, row = TP + b;
    const int w = 2 << (c >> 9);
    float x[8], s[8];
    unpack8(*(const uint4*)(Bb + (size_t)row * 2048 + c), x);
#pragma unroll
    for (int q = 0; q < 8; ++q) s[q] = x[q];
    const float* hp = hist + ((size_t)b * 15) * 2048 + c;
    for (int j = 1; j < w; ++j) {
      const f32x4 y0 = *(const f32x4*)(hp + (size_t)(15 - j) * 2048);
      const f32x4 y1 = *(const f32x4*)(hp + (size_t)(15 - j) * 2048 + 4);
#pragma unroll
      for (int q = 0; q < 4; ++q) { s[q] += y0[q]; s[4 + q] += y1[q]; }
    }
    const float inv = 1.f / (float)w;
#pragma unroll
    for (int q = 0; q < 8; ++q) s[q] = s[q] * inv - x[q];
    store8bf(Ab + (size_t)row * 2048 + c, s);
  }
}

DI void phase_spatial(const Params& p, char* smem_base, const int sub, const int tid0, int vb, int nb) {
  char* smem = smem_base + sub * LDS_SUB;
  char* ws = p.ws;
  const u16* W16 = (const u16*)(ws + W_1WS);
  u16* Ab = (u16*)(ws + W_A);
  const u16* Bb = (const u16*)(ws + W_B);
  const u16* Cb = (const u16*)(ws + W_C);
  const float* lnstat = (const float*)(ws + W_STAT) + (size_t)5 * T;
  const float* ln_g = p.in[13];
  const float* ln_b = p.in[14];
  const float* wsf = p.in[15];
  const float* b_s = p.in[16];
  for (int t = vb; t < 128 * 16; t += nb) {
    const int mt = t >> 4, g = (t >> 2) & 3, nt = t & 3;
    const u16* Ap = W16 + (size_t)g * 128 * 128;
    auto aload = [&](int r, int k) -> uint4 { return *(const uint4*)(Ap + (size_t)r * 128 + k); };
    auto bload = [&](int nl, int k) -> uint4 {
      const int c = g * 512 + nt * 128 + nl;
      const float lg = ln_g[c], lb = ln_b[c];
      float o[8];
#pragma unroll
      for (int jj = 0; jj < 8; ++jj) {
        const int row = mt * 128 + k + jj;
        const float x = bf2f(Bb[(size_t)row * 2048 + c]);
        const float2 stt = *(const float2*)(lnstat + (size_t)row * 2);
        const float mu = stt.x * (1.f / 2048.f);
        const float var = stt.y * (1.f / 2048.f) - mu * mu;
        o[jj] = (x - mu) * rsqrtf(var + EPS) * lg + lb;
      }
      return pack8(o);
    };
    auto epi = [&](int rl, int cl, const f32x4& v0, const f32x4& v1) {
      const int row = mt * 128 + rl, col = g * 512 + nt * 128 + cl;
      const float bs = b_s[g * 128 + rl];
      float u[8], z[8], v[8];
      unpack8(*(const uint4*)(Ab + (size_t)row * 2048 + col), u);
      unpack8(*(const uint4*)(Cb + (size_t)row * 2048 + col), z);
#pragma unroll
      for (int q = 0; q < 4; ++q) { v[q] = (v0[q] + bs) * u[q] * z[q]; v[4 + q] = (v1[q] + bs) * u[4 + q] * z[4 + q]; }
      store8bf(Ab + (size_t)row * 2048 + col, v);
    };
    gemm_tile(smem, tid0, 2, aload, bload, epi);
  }
  const int gtid = vb * 256 + tid0, gn = nb * 256;
  for (int i = gtid; i < 128 * 256; i += gn) {
    const int b = i >> 8, c = (i & 255) * 8, row = TP + b, g = c >> 9;
    const float2 stt = *(const float2*)(lnstat + (size_t)row * 2);
    const float mu = stt.x * (1.f / 2048.f);
    const float rstd = rsqrtf(stt.y * (1.f / 2048.f) - mu * mu + EPS);
    const float w00 = wsf[(size_t)g * 128 * 128], bs = b_s[g * 128];
    float x[8], u[8], z[8], vn[8], o[8];
    unpack8(*(const uint4*)(Bb + (size_t)row * 2048 + c), x);
    unpack8(*(const uint4*)(Ab + (size_t)row * 2048 + c), u);
    unpack8(*(const uint4*)(Cb + (size_t)row * 2048 + c), z);
#pragma unroll
    for (int q = 0; q < 8; ++q) {
      vn[q] = (x[q] - mu) * rstd * ln_g[c + q] + ln_b[c + q];
      o[q] = (w00 * vn[q] + bs) * u[q] * z[q];
    }
    store8f(p.out + O_SGUV + (size_t)b * 2048 + c, vn);
    store8bf(Ab + (size_t)row * 2048 + c, o);
  }
}

DI void phase_chunkprep(const Params& p, char* smem_base, const int sub, const int tid0, int vb, int nb) {
  char* smem = smem_base + sub * LDS_SUB;
  char* ws = p.ws;
  const int tid = tid0, lane = tid & 63, wid = tid >> 6, fr = lane & 15, fq = lane >> 4;
  u16* Bb = (u16*)(ws + W_B);
  u16* Cb = (u16*)(ws + W_C);
  const u16* halo = (const u16*)(ws + W_A + A_HALO);
  u16* KTT = (u16*)(ws + W_A + A_KTT);
  u16* QK = (u16*)(ws + W_A + A_QK);
  const float* Gb = (const float*)(ws + W_G);
  const float* Betab = (const float*)(ws + W_BETA);
  float* alast = (float*)(ws + W_ALAST);
  const float* cw = p.in[20];
  u16* q_s = (u16*)smem;
  u16* k_s = q_s + 64 * 136;
  u16* v_s = k_s + 64 * 136;
  typedef __attribute__((address_space(3))) float lds_f32;
  lds_f32* M_s = (lds_f32*)(smem + 3 * 64 * 136 * 2);
  asm volatile("" : "+v"(M_s));
  lds_f32* gam_s = M_s + 4096;
  lds_f32* beta_s = gam_s + 64;
  lds_f32* eg_s = beta_s + 64;
  const int subl = vb & 1;
#pragma unroll 1
  for (int seg = 0; seg < 2; ++seg) {
  if ((seg ^ subl) == 0) {
  for (int it = vb; it < 2048; it += nb) {
    const int cgi = it >> 3, h = it & 7;
    const int row0 = cgi * 64;
    const bool has_prev = (cgi & 31) != 0;
    lds_barrier();
#pragma unroll 1
    for (int part = 0; part < 3; ++part) {
      const int ch = part * 1024 + h * 128 + 2 * lane;
      const u16* src = (part < 2) ? (Bb + part * 1024 + h * 128 + 2 * lane) : (Cb + h * 128 + 2 * lane);
      float c0[4], c1[4];
#pragma unroll
      for (int j = 0; j < 4; ++j) { c0[j] = cw[j * 3072 + ch]; c1[j] = cw[j * 3072 + ch + 1]; }
      const int i0 = 16 * wid;
      float xa[3], xb[3];
#pragma unroll
      for (int j = 0; j < 3; ++j) {
        unsigned u = 0;
        if (i0 > 0) u = *(const unsigned*)(src + (size_t)(row0 + i0 - 3 + j) * 2048);
        else if (has_prev) u = *(const unsigned*)(halo + ((size_t)((cgi - 1) * 3 + j) * 3072) + ch);
        xa[j] = __uint_as_float(u << 16); xb[j] = __uint_as_float(u & 0xffff0000u);
      }
      u16* dst = (part == 0) ? q_s : (part == 1 ? k_s : v_s);
      unsigned xr[16];
#pragma unroll
      for (int r = 0; r < 16; ++r) xr[r] = *(const unsigned*)(src + (size_t)(row0 + i0 + r) * 2048);
      float ya[16], yb[16];
#pragma unroll
      for (int r = 0; r < 16; ++r) {
        const float na = __uint_as_float(xr[r] << 16), nb2 = __uint_as_float(xr[r] & 0xffff0000u);
        const float a = xa[0] * c0[0] + xa[1] * c0[1] + xa[2] * c0[2] + na * c0[3];
        const float bq = xb[0] * c1[0] + xb[1] * c1[1] + xb[2] * c1[2] + nb2 * c1[3];
        xa[0] = xa[1]; xa[1] = xa[2]; xa[2] = na;
        xb[0] = xb[1]; xb[1] = xb[2]; xb[2] = nb2;
        ya[r] = silu_f(a); yb[r] = silu_f(bq);
      }
      if (part < 2) {
        float ss[16];
#pragma unroll
        for (int r = 0; r < 16; ++r) ss[r] = ya[r] * ya[r] + yb[r] * yb[r];
#pragma unroll
        for (int o = 32; o > 0; o >>= 1)
#pragma unroll
          for (int r = 0; r < 16; ++r) ss[r] += __shfl_xor(ss[r], o, 64);
#pragma unroll
        for (int r = 0; r < 16; ++r) {
          const float sc = rsqrtf(ss[r] + EPS) * (part == 0 ? 0.08838834764831845f : 1.f);
          ya[r] *= sc; yb[r] *= sc;
        }
      }
#pragma unroll
      for (int r = 0; r < 16; ++r) *(unsigned*)(dst + (i0 + r) * 136 + 2 * lane) = pack2(ya[r], yb[r]);
    }
    if (tid < 64) {
      float v = Gb[(size_t)(row0 + tid) * 8 + h];
#pragma unroll
      for (int d = 1; d < 64; d <<= 1) { const float tt = __shfl_up(v, d, 64); if (lane >= d) v += tt; }
      gam_s[tid] = v;
      eg_s[tid] = __expf(v);
      beta_s[tid] = Betab[(size_t)(row0 + tid) * 8 + h];
    }
    lds_barrier();
    {
      f32x4 kk[4], qk[4];
#pragma unroll
      for (int n = 0; n < 4; ++n) { kk[n] = f32x4{0.f, 0.f, 0.f, 0.f}; qk[n] = f32x4{0.f, 0.f, 0.f, 0.f}; }
#pragma unroll
      for (int ks = 0; ks < 4; ++ks) {
        const bf16x8 ak = *(const bf16x8*)(k_s + (16 * wid + fr) * 136 + ks * 32 + fq * 8);
        const bf16x8 aq = *(const bf16x8*)(q_s + (16 * wid + fr) * 136 + ks * 32 + fq * 8);
#pragma unroll
        for (int n = 0; n < 4; ++n) {
          const bf16x8 b = *(const bf16x8*)(k_s + (n * 16 + fr) * 136 + ks * 32 + fq * 8);
          kk[n] = __builtin_amdgcn_mfma_f32_16x16x32_bf16(ak, b, kk[n], 0, 0, 0);
          qk[n] = __builtin_amdgcn_mfma_f32_16x16x32_bf16(aq, b, qk[n], 0, 0, 0);
        }
      }
#pragma unroll
      for (int n = 0; n < 4; ++n)
#pragma unroll
        for (int j = 0; j < 4; ++j) {
          const int i = 16 * wid + fq * 4 + j, jc = n * 16 + fr;
          const float d = (i >= jc) ? __expf(gam_s[i] - gam_s[jc]) : 0.f;
          M_s[jc * 64 + i] = (i > jc) ? beta_s[i] * kk[n][j] * d : 0.f;
          QK[(size_t)it * 4096 + i * 64 + jc] = f2bf(qk[n][j] * d);
        }
    }
    lds_barrier();
    {
      typedef __attribute__((address_space(3))) f32x4 lds_f32x4;
      const int col = tid;
      const bool isu = col < 128;
      const u16* rsrc = isu ? (v_s + col) : (k_s + (col - 128));
      u16* gdst = isu ? (Cb + (size_t)row0 * 2048 + h * 128 + col) : (Bb + (size_t)row0 * 2048 + 1024 + h * 128 + (col - 128));
      typedef float f32x2v __attribute__((ext_vector_type(2)));
      f32x2v a2[32];
#pragma unroll
      for (int i = 0; i < 64; ++i) {
        float r = beta_s[i] * bf2f(rsrc[i * 136]);
        if (!isu) r *= eg_s[i];
        a2[i >> 1][i & 1] = r;
      }
#pragma unroll
      for (int j = 0; j < 63; ++j) {
        const float sj = a2[j >> 1][j & 1];
        const f32x2v sj2 = {sj, sj};
#pragma unroll
        for (int g = j / 4; g < 16; ++g) {
          const f32x4 m = *(const lds_f32x4*)(M_s + j * 64 + g * 4);
          if (g * 4 + 1 > j) { const f32x2v m01 = {m[0], m[1]}; a2[2 * g] -= m01 * sj2; }
          if (g * 4 + 3 > j) { const f32x2v m23 = {m[2], m[3]}; a2[2 * g + 1] -= m23 * sj2; }
        }
      }
#pragma unroll
      for (int i = 0; i < 64; ++i) gdst[(size_t)i * 2048] = f2bf(a2[i >> 1][i & 1]);
    }
    int te = tid;
    asm volatile("" : "+v"(te));
    for (int idx = te; idx < 64 * 16; idx += 256) {
      const int i = idx >> 4, d8 = (idx & 15) * 8;
      float f[8];
      unpack8(*(const uint4*)(q_s + i * 136 + d8), f);
      const float e = eg_s[i];
#pragma unroll
      for (int q = 0; q < 8; ++q) f[q] *= e;
      store8bf(Bb + (size_t)(row0 + i) * 2048 + h * 128 + d8, f);
    }
    {
      int tf = tid;
      asm volatile("" : "+v"(tf));
      const int d = tf & 127, half = tf >> 7;
      const float gl = gam_s[63];
#pragma unroll
      for (int i8 = 0; i8 < 4; ++i8) {
        const int ib = (half * 4 + i8) * 8;
        float f[8];
#pragma unroll
        for (int q = 0; q < 8; ++q) f[q] = bf2f(k_s[(ib + q) * 136 + d]) * __expf(gl - gam_s[ib + q]);
        store8bf(KTT + (size_t)it * 8192 + d * 64 + ib, f);
      }
      if (tid == 0) alast[it] = __expf(gl);
    }
  }

  } else {
  const float* S0all = p.in[4];
  const float* chist = p.in[3];
  float* oss = (float*)(ws + W_STAT) + (size_t)7 * T;
  float* wss = (float*)(ws + W_WSS);
  float* kss = (float*)(ws + W_KSS);
  float* egs = (float*)(ws + W_EGS);
  float* qf = (float*)smem;
  float* kf = qf + 128;
  float* vf = kf + 128;
  float* red = vf + 128;
  for (int it = vb; it < 1024; it += nb) {
    const int b = it >> 3, h = it & 7, row = TP + b;
    lds_barrier();
    if (wid < 3) {
      const int part = wid;
      float y[2];
#pragma unroll
      for (int cc = 0; cc < 2; ++cc) {
        const int d = 2 * lane + cc;
        const int ch = part * 1024 + h * 128 + d;
        const float xn = (part < 2) ? bf2f(Bb[(size_t)row * 2048 + part * 1024 + h * 128 + d]) : bf2f(Cb[(size_t)row * 2048 + h * 128 + d]);
        float a = xn * cw[3 * 3072 + ch];
#pragma unroll
        for (int j = 0; j < 3; ++j) a += chist[((size_t)(b * 3 + j) * 3072) + ch] * cw[j * 3072 + ch];
        y[cc] = silu_f(a);
      }
      if (part < 2) {
        const float ss = wave_sum(y[0] * y[0] + y[1] * y[1]);
        const float sc = rsqrtf(ss + EPS) * (part == 0 ? 0.08838834764831845f : 1.f);
        y[0] *= sc; y[1] *= sc;
      }
      float* dst = (part == 0) ? qf : (part == 1 ? kf : vf);
      dst[2 * lane] = y[0]; dst[2 * lane + 1] = y[1];
    }
    lds_barrier();
    const float g = Gb[(size_t)row * 8 + h], beta = Betab[(size_t)row * 8 + h];
    const float eg = __expf(g);
    const float* S0 = S0all + (size_t)it * 16384;
    {
      const int c4 = tid & 31, rg = tid >> 5;
      float ks[4] = {0.f, 0.f, 0.f, 0.f}, qs[4] = {0.f, 0.f, 0.f, 0.f};
#pragma unroll
      for (int r = 0; r < 16; ++r) {
        const int dk = rg * 16 + r;
        const f32x4 s = *(const f32x4*)(S0 + dk * 128 + c4 * 4);
        const float kv = kf[dk], qv = qf[dk];
#pragma unroll
        for (int e = 0; e < 4; ++e) { ks[e] += kv * s[e]; qs[e] += qv * s[e]; }
      }
#pragma unroll
      for (int e = 0; e < 4; ++e) { red[rg * 128 + c4 * 4 + e] = ks[e]; red[1024 + rg * 128 + c4 * 4 + e] = qs[e]; }
    }
    const float qkdot = wave_sum(qf[lane] * kf[lane] + qf[lane + 64] * kf[lane + 64]);
    lds_barrier();
    if (tid < 128) {
      const int dv = tid;
      float kS = 0.f, qS = 0.f;
#pragma unroll
      for (int rg = 0; rg < 8; ++rg) { kS += red[rg * 128 + dv]; qS += red[1024 + rg * 128 + dv]; }
      const float w = beta * (vf[dv] - eg * kS);
      const float o = eg * qS + qkdot * w;
      Cb[(size_t)row * 2048 + h * 128 + dv] = f2bf(o);
      wss[(size_t)it * 128 + dv] = w;
      kss[(size_t)it * 128 + dv] = kf[dv];
      const float s2 = wave_sum(o * o);
      if (lane == 0) atomicAdd(&oss[(size_t)row * 8 + h], s2);
      if (tid == 0) egs[it] = eg;
    }
  }
  }
  }
}

DI void phase_scan(const Params& p, char* smem, const int tid, int bid, int nb) {
  char* ws = p.ws;
  const int lane = tid & 63, wid = tid >> 6, fr = lane & 15, fq = lane >> 4;
  const int mt = wid >> 1, nt = wid & 1;
  const u16* Bb = (const u16*)(ws + W_B);
  u16* Cb = (u16*)(ws + W_C);
  const u16* KTT = (const u16*)(ws + W_A + A_KTT);
  const u16* QK = (const u16*)(ws + W_A + A_QK);
  const float* alast = (const float*)(ws + W_ALAST);
  float* oss = (float*)(ws + W_STAT) + (size_t)7 * T;
  u16* ST = (u16*)smem;
  u16* WT = ST + 32 * 136;
  for (int it = bid; it < 256; it += nb) {
    const int b = it >> 5, h = (it >> 2) & 7, sl = it & 3;
    f32x4 S0v = f32x4{0.f, 0.f, 0.f, 0.f}, S1v = f32x4{0.f, 0.f, 0.f, 0.f};
    __syncthreads();
    for (int i = tid; i < 32 * 136 / 2; i += 512) ((unsigned*)ST)[i] = 0u;
    __syncthreads();
#define SCAN_DECL(P) bf16x8 P##wk0, P##wk1, P##wk2, P##wk3, P##qd0, P##qd1, P##qd2, P##qd3, P##qk0, P##qk1, P##kt0, P##kt1; f32x4 P##uu; float P##al
#define SCAN_LOAD_OPS(nn, P) do { \
      const int cgi_ = b * 32 + (nn), item8_ = cgi_ * 8 + h, row0_ = cgi_ * 64; \
      P##al = alast[item8_]; \
      const u16* wkp_ = Bb + (size_t)(row0_ + 16 * mt + fr) * 2048 + 1024 + h * 128 + fq * 8; \
      const u16* qdp_ = Bb + (size_t)(row0_ + 16 * mt + fr) * 2048 + h * 128 + fq * 8; \
      P##wk0 = *(const bf16x8*)(wkp_); P##wk1 = *(const bf16x8*)(wkp_ + 32); P##wk2 = *(const bf16x8*)(wkp_ + 64); P##wk3 = *(const bf16x8*)(wkp_ + 96); \
      P##qd0 = *(const bf16x8*)(qdp_); P##qd1 = *(const bf16x8*)(qdp_ + 32); P##qd2 = *(const bf16x8*)(qdp_ + 64); P##qd3 = *(const bf16x8*)(qdp_ + 96); \
      const u16* qkp_ = QK + (size_t)item8_ * 4096 + (16 * mt + fr) * 64 + fq * 8; \
      P##qk0 = *(const bf16x8*)(qkp_); P##qk1 = *(const bf16x8*)(qkp_ + 32); \
      const u16* ktp_ = KTT + (size_t)item8_ * 8192 + (wid * 16 + fr) * 64 + fq * 8; \
      P##kt0 = *(const bf16x8*)(ktp_); P##kt1 = *(const bf16x8*)(ktp_ + 32); \
      const u16* upl_ = Cb + (size_t)(row0_ + 16 * mt + fq * 4) * 2048 + h * 128 + sl * 32 + nt * 16 + fr; \
      P##uu[0] = bf2f(upl_[0]); P##uu[1] = bf2f(upl_[2048]); P##uu[2] = bf2f(upl_[4096]); P##uu[3] = bf2f(upl_[6144]); \
    } while (0)
#define MFMA16(a, b, c) __builtin_amdgcn_mfma_f32_16x16x32_bf16((a), (b), (c), 0, 0, 0)
    SCAN_DECL(c_);
    SCAN_LOAD_OPS(0, c_);
#pragma unroll 1
    for (int n = 0; n < 32; ++n) {
      const int row0 = (b * 32 + n) * 64;
      SCAN_DECL(n_);
      SCAN_LOAD_OPS((n < 31 ? n + 1 : n), n_);
      u16* up = Cb + (size_t)(row0 + 16 * mt + fq * 4) * 2048 + h * 128 + sl * 32 + nt * 16 + fr;
      const u16* stp = ST + (nt * 16 + fr) * 136 + fq * 8;
      const bf16x8 bs0 = *(const bf16x8*)(stp), bs1 = *(const bf16x8*)(stp + 32), bs2 = *(const bf16x8*)(stp + 64), bs3 = *(const bf16x8*)(stp + 96);
      f32x4 aw = f32x4{0.f, 0.f, 0.f, 0.f};
      aw = MFMA16(c_wk0, bs0, aw); aw = MFMA16(c_wk1, bs1, aw); aw = MFMA16(c_wk2, bs2, aw); aw = MFMA16(c_wk3, bs3, aw);
      {
        uint2 pk;
        pk.x = pack2(c_uu[0] - aw[0], c_uu[1] - aw[1]);
        pk.y = pack2(c_uu[2] - aw[2], c_uu[3] - aw[3]);
        *(uint2*)(WT + (nt * 16 + fr) * 72 + 16 * mt + fq * 4) = pk;
      }
      lds_barrier();
      const u16* wtp = WT + fr * 72 + fq * 8;
      const bf16x8 bw00 = *(const bf16x8*)(wtp), bw01 = *(const bf16x8*)(wtp + 32);
      const bf16x8 bw10 = *(const bf16x8*)(wtp + 16 * 72), bw11 = *(const bf16x8*)(wtp + 16 * 72 + 32);
      f32x4 ao = f32x4{0.f, 0.f, 0.f, 0.f};
      ao = MFMA16(c_qd0, bs0, ao); ao = MFMA16(c_qd1, bs1, ao); ao = MFMA16(c_qd2, bs2, ao); ao = MFMA16(c_qd3, bs3, ao);
      ao = MFMA16(c_qk0, nt ? bw10 : bw00, ao); ao = MFMA16(c_qk1, nt ? bw11 : bw01, ao);
#pragma unroll
      for (int j = 0; j < 4; ++j) {
        const float s2 = sum16(ao[j] * ao[j]);
        if (fr == 0) atomicAdd(&oss[(size_t)(row0 + 16 * mt + fq * 4 + j) * 8 + h], s2);
        up[(size_t)j * 2048] = f2bf(ao[j]);
      }
      f32x4 s0 = S0v * c_al, s1 = S1v * c_al;
      s0 = MFMA16(c_kt0, bw00, s0); s0 = MFMA16(c_kt1, bw01, s0);
      s1 = MFMA16(c_kt0, bw10, s1); s1 = MFMA16(c_kt1, bw11, s1);
      S0v = s0; S1v = s1;
      {
        uint2 pk;
        pk.x = pack2(s0[0], s0[1]); pk.y = pack2(s0[2], s0[3]);
        *(uint2*)(ST + fr * 136 + wid * 16 + fq * 4) = pk;
        pk.x = pack2(s1[0], s1[1]); pk.y = pack2(s1[2], s1[3]);
        *(uint2*)(ST + (16 + fr) * 136 + wid * 16 + fq * 4) = pk;
      }
      lds_barrier();
      c_wk0 = n_wk0; c_wk1 = n_wk1; c_wk2 = n_wk2; c_wk3 = n_wk3; c_qd0 = n_qd0; c_qd1 = n_qd1; c_qd2 = n_qd2; c_qd3 = n_qd3;
      c_qk0 = n_qk0; c_qk1 = n_qk1; c_kt0 = n_kt0; c_kt1 = n_kt1; c_uu = n_uu; c_al = n_al;
    }
    float* dst = p.out + O_DNP + (size_t)(b * 8 + h) * 16384;
#pragma unroll
    for (int j = 0; j < 4; ++j) {
      dst[(wid * 16 + fq * 4 + j) * 128 + sl * 32 + fr] = S0v[j];
      dst[(wid * 16 + fq * 4 + j) * 128 + sl * 32 + 16 + fr] = S1v[j];
    }
  }
}
DI void phase_final(const Params& p, const int gtid, const int gn) {
  char* ws = p.ws;
  const float* sumsq = (const float*)(ws + W_STAT) + (size_t)4 * T;
  const float* gain = p.in[30];
  float* y = p.out + O_Y;
  for (int base = gtid; base < T * 256; base += 8 * gn) {
    f32x4 v[8]; float rs[8]; f32x4 g[8];
#pragma unroll
    for (int u = 0; u < 8; ++u) {
      const int i = base + u * gn;
      if (i < T * 256) {
        const int row = i >> 8, c = (i & 255) * 4;
        v[u] = *(const f32x4*)(y + (size_t)row * 1024 + c);
        rs[u] = sumsq[row];
        g[u] = *(const f32x4*)(gain + c);
      }
    }
#pragma unroll
    for (int u = 0; u < 8; ++u) {
      const int i = base + u * gn;
      if (i < T * 256) {
        const int row = i >> 8, c = (i & 255) * 4;
        const float r = rsqrtf(rs[u] * (1.f / 1024.f) + EPS);
        f32x4 o;
#pragma unroll
        for (int q = 0; q < 4; ++q) o[q] = v[u][q] * r * g[u][q];
        *(f32x4*)(y + (size_t)row * 1024 + c) = o;
      }
    }
  }
  const float* S0 = p.in[4];
  const float* wss = (const float*)(ws + W_WSS);
  const float* kss = (const float*)(ws + W_KSS);
  const float* egs = (const float*)(ws + W_EGS);
  float* dS = p.out + O_DNS;
  for (int base = gtid; base < 1024 * 4096; base += 8 * gn) {
    f32x4 sv[8];
#pragma unroll
    for (int u = 0; u < 8; ++u) { const int i = base + u * gn; if (i < 1024 * 4096) sv[u] = *(const f32x4*)(S0 + (size_t)i * 4); }
#pragma unroll
    for (int u = 0; u < 8; ++u) {
      const int i = base + u * gn;
      if (i < 1024 * 4096) {
        const int it = i >> 12, dk = (i >> 5) & 127, dv = (i & 31) * 4;
        const float eg = egs[it], kv = kss[it * 128 + dk];
        const f32x4 w = *(const f32x4*)(wss + it * 128 + dv);
        f32x4 o;
#pragma unroll
        for (int q = 0; q < 4; ++q) o[q] = eg * sv[u][q] + kv * w[q];
        *(f32x4*)(dS + (size_t)i * 4) = o;
      }
    }
  }
}

DI void grid_barrier(unsigned* bar, int bid, int nb, unsigned k, int tid) {
  __syncthreads();
  if (tid == 0) {
    __threadfence();
    unsigned* gc = bar + (bid & 7) * 64;
    unsigned* top = bar + 8 * 64;
    const unsigned gsz = (unsigned)nb >> 3;
    const unsigned old = __hip_atomic_fetch_add(gc, 1u, __ATOMIC_RELAXED, __HIP_MEMORY_SCOPE_AGENT);
    if (old == gsz * k - 1u) __hip_atomic_fetch_add(top, 1u, __ATOMIC_RELAXED, __HIP_MEMORY_SCOPE_AGENT);
    while (__hip_atomic_load(top, __ATOMIC_RELAXED, __HIP_MEMORY_SCOPE_AGENT) < 8u * k) __builtin_amdgcn_s_sleep(1);
    __threadfence();
  }
  __syncthreads();
}

__global__ void __launch_bounds__(512) mega(Params p, int ph_lo, int ph_hi, int coop) {
  __shared__ __attribute__((aligned(16))) char smem[LDS_BYTES];
  const int nb = gridDim.x;
  const int bid = blockIdx.x;
  const int vb = ((nb & 7) == 0) ? ((bid & 7) * (nb >> 3) + (bid >> 3)) : bid;
#pragma unroll 1
  for (int ph = ph_lo; ph < ph_hi; ++ph) {
    Params q = p;
    int vbl = vb, nbl = nb, bidl = bid;
    long zoff = 0;
    asm volatile("" : "+s"(zoff), "+s"(vbl), "+s"(nbl), "+s"(bidl));
    q.ws = p.ws + zoff; q.out = p.out + zoff;
    const int tid = TID();
    const int sub = tid >> 8, tid2 = tid & 255;
    const int vsb = vbl * 2 + sub, nsb = nbl * 2;
    switch (ph) {
      case 0: if (PH_MASK & (1 << 0)) phase_prep(q, smem, sub, tid2, vsb, nsb); break;
      case 1: if (PH_MASK & (1 << 1)) phase_inproj<0>(q, smem, tid, bidl, nbl, 0); break;
      case 2: if (PH_MASK & (1 << 2)) phase_poolpass(q, vbl * 512 + tid, nbl * 512, 0); break;
      case 3: if (PH_MASK & (1 << 3)) phase_poolgrp(q, smem, tid, bidl, nbl, 0); break;
      case 4: if (PH_MASK & (1 << 4)) phase_outproj(q, smem, tid, bidl, nbl, 0, 1); break;
      case 5: if (PH_MASK & (1 << 5)) phase_inproj<1>(q, smem, tid, bidl, nbl, 1); break;
      case 6: if (PH_MASK & (1 << 6)) phase_spatial(q, smem, sub, tid2, vsb, nsb); break;
      case 7: if (PH_MASK & (1 << 7)) phase_outproj(q, smem, tid, bidl, nbl, 1, 0); break;
      case 8: if (PH_MASK & (1 << 8)) phase_inproj<2>(q, smem, tid, bidl, nbl, 2); break;
      case 9: if (PH_MASK & (1 << 9)) phase_chunkprep(q, smem, sub, tid2, vsb, nsb); break;
      case 10: if (PH_MASK & (1 << 10)) phase_scan(q, smem, tid, bidl, nbl); break;
      case 11: if (PH_MASK & (1 << 11)) phase_ogate(q, vbl * 512 + tid, nbl * 512); break;
      case 12: if (PH_MASK & (1 << 12)) phase_outproj(q, smem, tid, bidl, nbl, 2, 2); break;
      case 13: if (PH_MASK & (1 << 13)) phase_inproj<0>(q, smem, tid, bidl, nbl, 3); break;
      case 14: if (PH_MASK & (1 << 14)) phase_poolpass(q, vbl * 512 + tid, nbl * 512, 3); break;
      case 15: if (PH_MASK & (1 << 15)) phase_poolgrp(q, smem, tid, bidl, nbl, 3); break;
      case 16: if (PH_MASK & (1 << 16)) phase_outproj(q, smem, tid, bidl, nbl, 3, 1); break;
      case 17: if (PH_MASK & (1 << 17)) phase_final(q, vbl * 512 + tid, nbl * 512); break;
      default: break;
    }
    if (coop && ph + 1 < ph_hi) {
      if (ph == ph_lo) cg::this_grid().sync();
      else grid_barrier((unsigned*)(p.ws + W_BAR), bid, nb, (unsigned)(ph - ph_lo), TID());
    }
  }
}

extern "C" void kernel_launch(void* const* d_in, const int* in_sizes, int n_in, void* d_out, int out_size, void* d_ws,
                              size_t ws_size, hipStream_t stream) {
  static int grid_blocks = 0;
  if (!grid_blocks) {
    int dev = 0, cus = 0, per_cu = 0;
    (void)hipGetDevice(&dev);
    (void)hipDeviceGetAttribute(&cus, hipDeviceAttributeMultiprocessorCount, dev);
    (void)hipOccupancyMaxActiveBlocksPerMultiprocessor(&per_cu, mega, 512, 0);
    if (per_cu < 1) fprintf(stderr, "occupancy query returned %d\n", per_cu);
    grid_blocks = cus;
  }
  Params p{};
  for (int i = 0; i < 31; ++i) p.in[i] = (const float*)d_in[i];
  p.out = (float*)d_out;
  p.ws = (char*)d_ws;
  if (ws_size < W_END) { fprintf(stderr, "workspace too small: %zu < %zu\n", ws_size, (size_t)W_END); }
#if MULTI_LAUNCH
  for (int ph = 0; ph < NPHASE; ++ph) {
    for (int rep = 0; rep < 1 + ((DUP_MASK >> ph) & 1); ++rep)
      hipLaunchKernelGGL(mega, dim3(grid_blocks), dim3(512), 0, stream, p, ph, ph + 1, 0);
  }
#else
  (void)hipMemsetAsync((char*)d_ws + W_BAR, 0, 4096, stream);
  int lo = 0, hi = NPHASE, coop = 1;
  void* args[] = {&p, &lo, &hi, &coop};
  hipError_t e = hipLaunchCooperativeKernel((void*)mega, dim3(grid_blocks), dim3(512), args, 0, stream);
  if (e != hipSuccess) fprintf(stderr, "cooperative launch failed: %s (grid %d)\n", hipGetErrorString(e), grid_blocks);
#endif
}
```
